# Optimizing an MI355X kernel written in HIP

```python
import math
import jax, jax.numpy as jnp
from jax import lax
import numpy as np

D_MODEL = 1024
BATCH = 16
SEQ = 4096
DEPTH = 2

HEAD_DIM = 64
SCALE = HEAD_DIM ** -0.5
ROPE_THETA = 10000.0
NORM_EPS = 1e-5
BAND = 128

A_HEADS = 8
A_KV_HEADS = 2
A_GROUP = A_HEADS // A_KV_HEADS
CMP_BLOCK = 32
CMP_STRIDE = 16
CMP_HIDDEN = 256
SEL_BLOCK = 64
SEL_TOPK = 16
NSA_WINDOW = 512
NSA_QBLOCK = 64
N_BRANCH = 3

B_HEADS = 8
B_KV_HEADS = 2
B_GROUP = B_HEADS // B_KV_HEADS
B_WINDOW = 128

C_HEADS = 16
C_PATTERNS = ((128, 1), (512, 4), (2048, 16))

A_Q = A_HEADS * HEAD_DIM
A_KV = A_KV_HEADS * HEAD_DIM
A_GATES = A_HEADS * N_BRANCH
B_Q = B_HEADS * HEAD_DIM
B_KV = B_KV_HEADS * HEAD_DIM
EVEN_IN = A_Q + 6 * A_KV + A_GATES + B_Q + 2 * B_KV
EVEN_MIX = A_Q + B_Q
ODD_IN = 3 * C_HEADS * HEAD_DIM
ODD_MIX = C_HEADS * HEAD_DIM
FFN_HIDDEN = -(-8 * D_MODEL // (3 * 256)) * 256
N_EVEN = (DEPTH + 1) // 2
N_ODD = DEPTH // 2

kernel_name = "hybrid_nsa_swasink_dilated_swiglu"


def rms_norm(x, g):
    xf = x.astype(jnp.float32)
    y = xf * lax.rsqrt(jnp.mean(xf * xf, axis=-1, keepdims=True) + NORM_EPS)
    return (y * g.astype(jnp.float32)).astype(x.dtype)


def rope_tables(seq, dtype):
    inv = 1.0 / (ROPE_THETA ** (jnp.arange(0, HEAD_DIM, 2, dtype=jnp.float32) / HEAD_DIM))
    ang = jnp.arange(seq, dtype=jnp.float32)[:, None] * inv[None, :]
    ang = jnp.concatenate([ang, ang], axis=-1)
    return jnp.cos(ang).astype(dtype), jnp.sin(ang).astype(dtype)


def apply_rope(x, cos, sin):
    x1, x2 = jnp.split(x, 2, axis=-1)
    rot = jnp.concatenate([-x2, x1], axis=-1)
    return x * cos[:, None, :] + rot * sin[:, None, :]


def banded_attention(q, k, v, reach, sink=None):
    L, dh = q.shape[-2], q.shape[-1]
    nb = -(-L // BAND)
    pad = nb * BAND - L
    if pad:
        q = jnp.pad(q, [(0, 0)] * (q.ndim - 2) + [(0, pad), (0, 0)])
        k = jnp.pad(k, [(0, 0)] * (k.ndim - 2) + [(0, pad), (0, 0)])
        v = jnp.pad(v, [(0, 0)] * (v.ndim - 2) + [(0, pad), (0, 0)])
    qb = q.reshape(q.shape[:-2] + (nb, BAND, dh))
    kb = k.reshape(k.shape[:-2] + (nb, BAND, dh))
    vb = v.reshape(v.shape[:-2] + (nb, BAND, dh))

    def with_prev(t):
        prev = jnp.pad(t, [(0, 0)] * (t.ndim - 3) + [(1, 0), (0, 0), (0, 0)])[..., :-1, :, :]
        return jnp.concatenate([prev, t], axis=-2)

    kc, vc = with_prev(kb), with_prev(vb)
    s = jnp.einsum('...gnqd,...nkd->...gnqk', qb, kc, preferred_element_type=jnp.float32) * SCALE
    qi = jnp.arange(BAND)[:, None] + BAND
    kj = jnp.arange(2 * BAND)[None, :]
    diff = qi - kj
    mask = (diff >= 0) & (diff <= reach)
    not_before_start = (jnp.arange(nb)[:, None, None] > 0) | (kj[None] >= BAND)
    mask = mask[None] & not_before_start
    s = jnp.where(mask, s, -jnp.inf)
    m = jnp.max(s, axis=-1)
    if sink is not None:
        m = jnp.maximum(m, sink)
    p = jnp.exp(s - m[..., None])
    den = jnp.sum(p, axis=-1)
    if sink is not None:
        den = den + jnp.exp(sink - m)
    o = jnp.einsum('...gnqk,...nkd->...gnqd', p, vc.astype(jnp.float32)) / den[..., None]
    o = o.reshape(q.shape[:-2] + (nb * BAND, dh))[..., :L, :]
    lse = (m + jnp.log(den)).reshape(q.shape[:-2] + (nb * BAND,))[..., :L]
    return o, lse


def compress_blocks(t, pe, w1, w2):
    bsz, hkv, seq, dh = t.shape
    chunks = t.reshape(bsz, hkv, seq // CMP_STRIDE, CMP_STRIDE, dh)
    blocks = jnp.concatenate([chunks[:, :, :-1], chunks[:, :, 1:]], axis=-2)
    nc = blocks.shape[2]
    blocks = (blocks + pe).reshape(bsz, hkv, nc, CMP_BLOCK * dh)
    return jax.nn.silu(blocks @ w1) @ w2


def nsa_attention(q_plain, q_rot, k_cmp, v_cmp, k_sel, v_sel, k_win, v_win, gates,
                  pe_k, pe_v, wk1, wk2, wv1, wv2):
    bsz, seq = q_plain.shape[:2]
    dh = HEAD_DIM
    nc = seq // CMP_STRIDE - 1
    nb = seq // SEL_BLOCK
    n_sel = min(SEL_TOPK, nb)

    def group_q(t):
        return t.reshape(bsz, seq, A_KV_HEADS, A_GROUP, dh).transpose(0, 2, 3, 1, 4)

    def heads_first(t):
        return t.transpose(0, 2, 1, 3)

    qp, qr = group_q(q_plain), group_q(q_rot)
    g = gates.reshape(bsz, seq, A_KV_HEADS, A_GROUP, N_BRANCH).transpose(0, 2, 3, 1, 4)
    kc = compress_blocks(heads_first(k_cmp), pe_k, wk1, wk2)
    vc = compress_blocks(heads_first(v_cmp), pe_v, wv1, wv2).astype(jnp.float32)
    ks_b = heads_first(k_sel).reshape(bsz, A_KV_HEADS, nb, SEL_BLOCK, dh)
    vs_b = heads_first(v_sel).reshape(bsz, A_KV_HEADS, nb, SEL_BLOCK, dh)
    pad_w = ((0, 0), (0, 0), (NSA_WINDOW, 0), (0, 0))
    kw_p = jnp.pad(heads_first(k_win), pad_w)
    vw_p = jnp.pad(heads_first(v_win), pad_w)

    cmp_end = jnp.arange(nc) * CMP_STRIDE + CMP_BLOCK - 1
    c_start = np.arange(nc) * CMP_STRIDE
    s_start = np.arange(nb) * SEL_BLOCK
    overlap = ((c_start[:, None] <= s_start[None, :] + SEL_BLOCK - 1) &
               (c_start[:, None] + CMP_BLOCK - 1 >= s_start[None, :]))
    cmp_to_sel = jnp.asarray(overlap.astype(np.float32))
    bi = jnp.arange(bsz)[:, None, None, None]
    hi = jnp.arange(A_KV_HEADS)[None, :, None, None]
    blk = jnp.arange(nb)[None, :]

    def query_block(i):
        q0 = i * NSA_QBLOCK
        tq = q0 + jnp.arange(NSA_QBLOCK)
        qp_b = lax.dynamic_slice_in_dim(qp, q0, NSA_QBLOCK, axis=3)
        qr_b = lax.dynamic_slice_in_dim(qr, q0, NSA_QBLOCK, axis=3)
        g_b = lax.dynamic_slice_in_dim(g, q0, NSA_QBLOCK, axis=3).astype(jnp.float32)

        s = jnp.einsum('bhgqd,bhcd->bhgqc', qp_b, kc, preferred_element_type=jnp.float32) * SCALE
        s = jnp.where(cmp_end[None, :] <= tq[:, None], s, -jnp.inf)
        m = jnp.max(s, axis=-1, keepdims=True)
        m = jnp.where(jnp.isfinite(m), m, 0.0)
        p = jnp.exp(s - m)
        den = jnp.sum(p, axis=-1, keepdims=True)
        p = p / jnp.where(den > 0, den, 1.0)
        o_cmp = jnp.einsum('bhgqc,bhcd->bhgqd', p, vc)

        imp = jnp.einsum('bhgqc,cn->bhqn', p, cmp_to_sel)
        cur = (tq // SEL_BLOCK)[:, None]
        forced = (blk == 0) | (blk == cur) | (blk == cur - 1)
        imp = jnp.where(forced, jnp.inf, jnp.where(blk > cur, -jnp.inf, imp))
        _, idx = lax.top_k(imp, n_sel)
        kg = ks_b[bi, hi, idx].reshape(bsz, A_KV_HEADS, NSA_QBLOCK, n_sel * SEL_BLOCK, dh)
        vg = vs_b[bi, hi, idx].reshape(bsz, A_KV_HEADS, NSA_QBLOCK, n_sel * SEL_BLOCK, dh)
        pos = (idx[..., None] * SEL_BLOCK + jnp.arange(SEL_BLOCK)).reshape(
            bsz, A_KV_HEADS, NSA_QBLOCK, n_sel * SEL_BLOCK)
        s = jnp.einsum('bhgqd,bhqkd->bhgqk', qr_b, kg, preferred_element_type=jnp.float32) * SCALE
        s = jnp.where((pos <= tq[:, None])[:, :, None], s, -jnp.inf)
        o_sel = jnp.einsum('bhgqk,bhqkd->bhgqd', jax.nn.softmax(s, axis=-1), vg.astype(jnp.float32))

        kw = lax.dynamic_slice_in_dim(kw_p, q0, NSA_QBLOCK + NSA_WINDOW, axis=2)
        vw = lax.dynamic_slice_in_dim(vw_p, q0, NSA_QBLOCK + NSA_WINDOW, axis=2)
        kpos = q0 - NSA_WINDOW + jnp.arange(NSA_QBLOCK + NSA_WINDOW)
        diff = tq[:, None] - kpos[None, :]
        wmask = (diff >= 0) & (diff < NSA_WINDOW) & (kpos[None, :] >= 0)
        s = jnp.einsum('bhgqd,bhkd->bhgqk', qr_b, kw, preferred_element_type=jnp.float32) * SCALE
        s = jnp.where(wmask, s, -jnp.inf)
        o_win = jnp.einsum('bhgqk,bhkd->bhgqd', jax.nn.softmax(s, axis=-1), vw.astype(jnp.float32))

        return g_b[..., 0:1] * o_cmp + g_b[..., 1:2] * o_sel + g_b[..., 2:3] * o_win

    out = lax.map(query_block, jnp.arange(seq // NSA_QBLOCK))
    out = out.transpose(1, 0, 4, 2, 3, 5)
    return out.reshape(bsz, seq, A_HEADS * dh)


def swa_sink_attention(q, k, v, sinks):
    bsz, seq = q.shape[:2]
    qg = q.reshape(bsz, seq, B_KV_HEADS, B_GROUP, HEAD_DIM).transpose(0, 2, 3, 1, 4)
    sink = sinks.astype(jnp.float32).reshape(B_KV_HEADS, B_GROUP, 1, 1)
    o, _ = banded_attention(qg, k.transpose(0, 2, 1, 3), v.transpose(0, 2, 1, 3), B_WINDOW - 1, sink)
    return o.transpose(0, 3, 1, 2, 4).reshape(bsz, seq, B_HEADS * HEAD_DIM)


def dilated_attention(q, k, v):
    bsz, seq, nh, dh = q.shape
    qt, kt, vt = (t.transpose(0, 2, 1, 3) for t in (q, k, v))
    outs, lses = [], []
    for window, dil in C_PATTERNS:
        sub = seq // dil

        def strided(t):
            return t.reshape(bsz, nh, sub, dil, dh).transpose(0, 1, 3, 2, 4)

        o, lse = banded_attention(strided(qt)[..., None, :, :], strided(kt), strided(vt), window // dil)
        outs.append(o[..., 0, :, :].transpose(0, 1, 3, 2, 4).reshape(bsz, nh, seq, dh))
        lses.append(lse[..., 0, :].transpose(0, 1, 3, 2).reshape(bsz, nh, seq))
    w = jax.nn.softmax(jnp.stack(lses, axis=0), axis=0)
    o = jnp.einsum('pbht,pbhtd->bhtd', w, jnp.stack(outs, axis=0))
    return o.transpose(0, 2, 1, 3).reshape(bsz, seq, nh * dh)


def setup_inputs(seed: int = 0) -> dict:
    key = jax.random.key(seed)
    ks = jax.random.split(key, 17)
    nrm = jax.random.normal
    f32 = jnp.float32
    return {
        "x": nrm(ks[0], (BATCH, SEQ, D_MODEL), f32),
        "attn_norm": 1.0 + 0.02 * nrm(ks[1], (DEPTH, D_MODEL), f32),
        "ffn_norm": 1.0 + 0.02 * nrm(ks[2], (DEPTH, D_MODEL), f32),
        "final_norm": 1.0 + 0.02 * nrm(ks[3], (D_MODEL,), f32),
        "w_in_e": nrm(ks[4], (N_EVEN, D_MODEL, EVEN_IN), f32) * D_MODEL ** -0.5,
        "w_out_e": nrm(ks[5], (N_EVEN, EVEN_MIX, D_MODEL), f32) * EVEN_MIX ** -0.5,
        "cmp_pe_k": 0.02 * nrm(ks[6], (N_EVEN, CMP_BLOCK, HEAD_DIM), f32),
        "cmp_pe_v": 0.02 * nrm(ks[7], (N_EVEN, CMP_BLOCK, HEAD_DIM), f32),
        "cmp_k_w1": nrm(ks[8], (N_EVEN, CMP_BLOCK * HEAD_DIM, CMP_HIDDEN), f32) * (CMP_BLOCK * HEAD_DIM) ** -0.5,
        "cmp_k_w2": nrm(ks[9], (N_EVEN, CMP_HIDDEN, HEAD_DIM), f32) * CMP_HIDDEN ** -0.5,
        "cmp_v_w1": nrm(ks[10], (N_EVEN, CMP_BLOCK * HEAD_DIM, CMP_HIDDEN), f32) * (CMP_BLOCK * HEAD_DIM) ** -0.5,
        "cmp_v_w2": nrm(ks[11], (N_EVEN, CMP_HIDDEN, HEAD_DIM), f32) * CMP_HIDDEN ** -0.5,
        "sinks": 0.5 * nrm(ks[12], (N_EVEN, B_HEADS), f32),
        "w_qkv_o": nrm(ks[13], (N_ODD, D_MODEL, ODD_IN), f32) * D_MODEL ** -0.5,
        "w_out_o": nrm(ks[14], (N_ODD, ODD_MIX, D_MODEL), f32) * ODD_MIX ** -0.5,
        "w_gate_up": nrm(ks[15], (DEPTH, D_MODEL, 2 * FFN_HIDDEN), f32) * D_MODEL ** -0.5,
        "w_down": nrm(ks[16], (DEPTH, FFN_HIDDEN, D_MODEL), f32) * FFN_HIDDEN ** -0.5,
    }


def reference(x, attn_norm, ffn_norm, final_norm, w_in_e, w_out_e, cmp_pe_k, cmp_pe_v,
              cmp_k_w1, cmp_k_w2, cmp_v_w1, cmp_v_w2, sinks, w_qkv_o, w_out_o,
              w_gate_up, w_down):
    bsz, seq, _ = x.shape
    cos, sin = rope_tables(seq, x.dtype)
    for layer in range(DEPTH):
        h = rms_norm(x, attn_norm[layer])
        if layer % 2 == 0:
            i = layer // 2
            z = h @ w_in_e[i]
            o1 = A_Q
            o2 = o1 + 6 * A_KV
            o3 = o2 + A_GATES
            o4 = o3 + B_Q
            aq = z[..., :o1].reshape(bsz, seq, A_HEADS, HEAD_DIM)
            akc, avc, aks, avs, akw, avw = [t.reshape(bsz, seq, A_KV_HEADS, HEAD_DIM)
                                            for t in jnp.split(z[..., o1:o2], 6, axis=-1)]
            gates = jax.nn.sigmoid(z[..., o2:o3].astype(jnp.float32)).reshape(bsz, seq, A_HEADS, N_BRANCH)
            bq = apply_rope(z[..., o3:o4].reshape(bsz, seq, B_HEADS, HEAD_DIM), cos, sin)
            bk, bv = [t.reshape(bsz, seq, B_KV_HEADS, HEAD_DIM) for t in jnp.split(z[..., o4:], 2, axis=-1)]
            bk = apply_rope(bk, cos, sin)
            a_out = nsa_attention(aq, apply_rope(aq, cos, sin), akc, avc,
                                  apply_rope(aks, cos, sin), avs, apply_rope(akw, cos, sin), avw, gates,
                                  cmp_pe_k[i], cmp_pe_v[i], cmp_k_w1[i], cmp_k_w2[i], cmp_v_w1[i], cmp_v_w2[i])
            b_out = swa_sink_attention(bq, bk, bv, sinks[i])
            mix = jnp.concatenate([a_out, b_out], axis=-1).astype(x.dtype)
            x = x + mix @ w_out_e[i]
        else:
            j = layer // 2
            z = h @ w_qkv_o[j]
            q, k, v = [t.reshape(bsz, seq, C_HEADS, HEAD_DIM) for t in jnp.split(z, 3, axis=-1)]
            c_out = dilated_attention(apply_rope(q, cos, sin), apply_rope(k, cos, sin), v)
            x = x + c_out.astype(x.dtype) @ w_out_o[j]
        h = rms_norm(x, ffn_norm[layer])
        gate, up = jnp.split(h @ w_gate_up[layer], 2, axis=-1)
        x = x + (jax.nn.silu(gate) * up) @ w_down[layer]
    return rms_norm(x, final_norm)
```

```cpp
#include <hip/hip_runtime.h>
#include <hip/hip_cooperative_groups.h>
#include <hip/hip_bf16.h>
#include <cstdio>
#include <cstdint>
namespace cg = cooperative_groups;
namespace pg8 {
#define PG8_LAS __attribute__((address_space(3)))
typedef unsigned short bf16_t;
typedef short bf16x8 __attribute__((ext_vector_type(8)));
typedef float f32x4 __attribute__((ext_vector_type(4)));
typedef unsigned u32x4 __attribute__((ext_vector_type(4)));
struct Unit { int pm, pn; };
constexpr int BM = 256, BK = 64, HALF = 128, HTB = HALF * BK * 2  , STAGE_BYTES = 8 * HTB, NXCD = 8, WGM = 4;

__host__ __device__ __forceinline__ int lds_byte(int r, int c) { const int st = (r >> 4) * 2 + (c >> 5), rr = r & 15, cc = c & 31, ob = rr * 64 + cc * 2; return st * 1024 + (ob ^ (((ob >> 9) & 1) << 5)); }
__host__ __device__ __forceinline__ void stage_rc(int b, int& R, int& C) { const int st = b / 1024, sb = b % 1024, swz = sb ^ (((sb >> 9) & 1) << 5); R = (st >> 1) * 16 + swz / 64; C = (st & 1) * 32 + (swz % 64) / 2; }
__host__ __device__ __forceinline__ int perm32(int rho) { const int n = rho >> 4, i = rho & 15; return 8 * (i >> 2) + 4 * n + (i & 3); }

struct Gemm { const bf16_t* A; const bf16_t* Bt; int M, N, K; int lda; int kstepA; int sh; long s1, s0, sp; };
__device__ __forceinline__ const char* a_base(const Gemm& g, const struct Unit& u);

struct StaticOrder {
    int nM, nN, nwg, G, c, rev;
    __host__ __device__ void init(int M, int N, int G_, int c_, int rev_ = 0) { nM = M / BM; nN = N / BM; nwg = nM * nN; G = G_; c = c_; rev = rev_; }
    __host__ __device__ bool next(int i, Unit& u) const {
        const long L = (long)i * G + c; if (L >= nwg) return false;
        int wgid = (int)L; { const int q = nwg / NXCD, r = nwg % NXCD, xcd = wgid % NXCD, off = wgid / NXCD; wgid = (xcd < r ? xcd * (q + 1) : r * (q + 1) + (xcd - r) * q) + off; }
        const int nig = WGM * nN, gid = wgid / nig, fm = gid * WGM, gsz = (nM - fm) < WGM ? (nM - fm) : WGM;
        u.pm = fm + ((wgid % nig) % gsz); u.pn = (wgid % nig) / gsz; if (rev) u.pm = nM - 1 - u.pm; return true;
    }
    __device__ __forceinline__ void a_ready(const Unit&) const {}
    __device__ __forceinline__ void done(const Unit&) const {}
};


__device__ __forceinline__ const char* a_base(const Gemm& g, const Unit& u) { return (const char*)g.A + (size_t)(u.pm >> g.sh) * g.s1 + (size_t)(u.pm & ((1 << g.sh) - 1)) * g.s0 + (size_t)u.pn * g.sp; }
template <class Epi, class Sched, bool ALIGN_EPI = false, bool SP2 = false>
__device__ __forceinline__ void gemm_phase(PG8_LAS unsigned char* lds, const Gemm g, const Sched& S, const Epi& E, int wave0) {
    int tid_; asm volatile("v_mbcnt_lo_u32_b32 %0, -1, 0\n\tv_mbcnt_hi_u32_b32 %0, -1, %0" : "=&v"(tid_)); tid_ += wave0 * 64; const int tid = tid_, wid = __builtin_amdgcn_readfirstlane(tid >> 6), lane = tid & 63, wr = wid >> 2, wc = wid & 3, fr = lane & 15, fq = lane >> 4;
    const int K = g.K, nt = K / BK;
    unsigned voffA[2], voffB[2];
#pragma unroll
    for (int i = 0; i < 2; ++i) { int R, C; stage_rc(tid * 16 + i * 8192, R, C); const int Rb = Epi::PERM ? ((R & ~31) + perm32(R & 31)) : R;
        voffA[i] = (unsigned)(R * g.lda + C) * 2u; voffB[i] = (unsigned)(Rb * K + C) * 2u; }
    const size_t kstep = (size_t)(BK * 2); const size_t kstepA = (size_t)g.kstepA; const size_t hstepA = (size_t)HALF * g.lda * 2;
    const size_t hstep = (size_t)HALF * K * 2;
    const size_t tstep = 2 * hstep;
    const unsigned ldsw = (unsigned)wid * 1024u;
    const int aoff = lds_byte(wr * 64 + fr, fq * 8), boff = lds_byte(wc * 32 + fr, fq * 8);
#define PG8_SA(b, h) (((b) * 2 + (h)) * HTB)
#define PG8_SB(b, h) ((4 + (b) * 2 + (h)) * HTB)
#define PG8_STAGE(bufoff, gbase, voff) do { _Pragma("unroll") for (int _i = 0; _i < 2; ++_i) \
        __builtin_amdgcn_global_load_lds((const unsigned*)((const char*)(gbase) + (voff)[_i]), (PG8_LAS unsigned*)(lds + (bufoff) + ldsw + _i * 8192), 16, 0, 0); } while (0)
#define PG8_LDA(dst, b, h) do { _Pragma("unroll") for (int m = 0; m < 4; ++m) _Pragma("unroll") for (int k = 0; k < 2; ++k) dst[m][k] = *(const PG8_LAS bf16x8*)(lds + PG8_SA(b, h) + aoff + m * 2048 + k * 1024); } while (0)
#define PG8_LDB(dst, b, h) do { _Pragma("unroll") for (int n = 0; n < 2; ++n) _Pragma("unroll") for (int k = 0; k < 2; ++k) dst[n][k] = *(const PG8_LAS bf16x8*)(lds + PG8_SB(b, h) + boff + n * 2048 + k * 1024); } while (0)
#define PG8_MMA(ai, bj, At, Bt) do { __builtin_amdgcn_s_setprio(1); _Pragma("unroll") for (int m = 0; m < 4; ++m) _Pragma("unroll") for (int n = 0; n < 2; ++n) _Pragma("unroll") for (int k = 0; k < 2; ++k) \
        acc[ai][bj][m][n] = __builtin_amdgcn_mfma_f32_16x16x32_bf16(Bt[n][k], At[m][k], acc[ai][bj][m][n], 0, 0, 0); __builtin_amdgcn_s_setprio(0); } while (0)
#define PG8_WAIT_V(n) asm volatile("s_waitcnt vmcnt(" #n ")" ::: "memory")
#define PG8_WAIT_L(n) asm volatile("s_waitcnt lgkmcnt(" #n ")" ::: "memory")
#define PG8_BAR __builtin_amdgcn_s_barrier()
#define PG8_SCHED __builtin_amdgcn_sched_barrier(0)
    Unit cur, nxt; int ui = 0;
    if (!S.next(0, cur)) return;
    f32x4 acc[2][2][4][2];
#pragma unroll
    for (int a = 0; a < 2; ++a)
#pragma unroll
        for (int b = 0; b < 2; ++b)
#pragma unroll
            for (int m = 0; m < 4; ++m)
#pragma unroll
                for (int n = 0; n < 2; ++n) acc[a][b][m][n] = (f32x4){0.f, 0.f, 0.f, 0.f};
    bf16x8 At[4][2], B0[2][2], B1[2][2];
    const char* cA = a_base(g, cur); const char* cB = (const char*)g.Bt + (size_t)cur.pn * tstep;
    S.a_ready(cur);
    if constexpr (SP2) {
        PG8_STAGE(PG8_SB(0, 0), cB, voffB); PG8_STAGE(PG8_SB(0, 1), cB + hstep, voffB); PG8_STAGE(PG8_SA(0, 0), cA, voffA); PG8_STAGE(PG8_SA(0, 1), cA + hstepA, voffA);
        if (wr == 1) PG8_BAR;
        PG8_WAIT_V(2); PG8_BAR;
        PG8_STAGE(PG8_SB(1, 0), cB + kstep, voffB); PG8_STAGE(PG8_SA(1, 0), cA + kstepA, voffA); PG8_STAGE(PG8_SB(1, 1), cB + hstep + kstep, voffB);
        PG8_WAIT_V(6); PG8_BAR;
    } else {
        PG8_STAGE(PG8_SB(0, 0), cB, voffB); PG8_STAGE(PG8_SA(0, 0), cA, voffA); PG8_STAGE(PG8_SB(0, 1), cB + hstep, voffB); PG8_STAGE(PG8_SA(0, 1), cA + hstepA, voffA);
        if (wr == 1) PG8_BAR;
        PG8_WAIT_V(4); PG8_BAR;
        PG8_STAGE(PG8_SB(1, 0), cB + kstep, voffB); PG8_STAGE(PG8_SA(1, 0), cA + kstepA, voffA); PG8_STAGE(PG8_SB(1, 1), cB + hstep + kstep, voffB);
        PG8_WAIT_V(6); PG8_BAR;
    }
    for (;;) {
        const bool has_next = S.next(ui + 1, nxt);
        const char* nA = has_next ? a_base(g, nxt) : cA; const char* nB = has_next ? (const char*)g.Bt + (size_t)nxt.pn * tstep : cB;
        for (int t = 0; t < nt; t += 2) {
            const bool last = (t == nt - 2);
            const char* a1 = cA + (size_t)(t + 1) * kstepA;
            const char* a2 = last ? nA : cA + (size_t)(t + 2) * kstepA; const char* b2 = last ? nB : cB + (size_t)(t + 2) * kstep;
            const char* a3 = a2 + kstepA; const char* b3 = b2 + kstep;
            if (last && has_next) S.a_ready(nxt);
            if constexpr (SP2) {
            PG8_LDB(B0, 0, 0); PG8_LDB(B1, 0, 1); PG8_SCHED; PG8_LDA(At, 0, 0); PG8_STAGE(PG8_SA(1, 1), a1 + hstepA, voffA);
            PG8_WAIT_V(8); PG8_WAIT_L(0); PG8_BAR; PG8_MMA(0, 0, At, B0); PG8_MMA(0, 1, At, B1); PG8_BAR; PG8_SCHED;
            PG8_LDA(At, 0, 1); PG8_STAGE(PG8_SB(0, 0), b2, voffB); PG8_STAGE(PG8_SB(0, 1), b2 + hstep, voffB); PG8_STAGE(PG8_SA(0, 0), a2, voffA);
            PG8_WAIT_V(8); PG8_WAIT_L(0); PG8_BAR; PG8_MMA(1, 0, At, B0); PG8_MMA(1, 1, At, B1); PG8_BAR; PG8_SCHED;
            PG8_LDB(B0, 1, 0); PG8_LDB(B1, 1, 1); PG8_SCHED; PG8_LDA(At, 1, 0); PG8_STAGE(PG8_SA(0, 1), a2 + hstepA, voffA);
            PG8_WAIT_V(8); PG8_WAIT_L(0); PG8_BAR; PG8_MMA(0, 0, At, B0); PG8_MMA(0, 1, At, B1); PG8_BAR; PG8_SCHED;
            PG8_LDA(At, 1, 1); PG8_STAGE(PG8_SB(1, 0), b3, voffB); PG8_STAGE(PG8_SB(1, 1), b3 + hstep, voffB); PG8_STAGE(PG8_SA(1, 0), a3, voffA);
            PG8_WAIT_V(8); PG8_WAIT_L(0); PG8_BAR; PG8_MMA(1, 0, At, B0); PG8_MMA(1, 1, At, B1); PG8_BAR; PG8_SCHED;
            } else {
            PG8_LDB(B0, 0, 0); PG8_SCHED; PG8_LDA(At, 0, 0); PG8_STAGE(PG8_SA(1, 1), a1 + hstepA, voffA);
            PG8_WAIT_L(8); PG8_BAR; PG8_WAIT_L(0); PG8_MMA(0, 0, At, B0); PG8_BAR; PG8_SCHED;
            PG8_LDB(B1, 0, 1); PG8_STAGE(PG8_SB(0, 0), b2, voffB);
            PG8_BAR; PG8_WAIT_L(0); PG8_MMA(0, 1, At, B1); PG8_BAR;
            PG8_LDA(At, 0, 1); PG8_STAGE(PG8_SA(0, 0), a2, voffA);
            PG8_BAR; PG8_WAIT_L(0); PG8_MMA(1, 0, At, B0); PG8_BAR; PG8_SCHED;
            PG8_STAGE(PG8_SB(0, 1), b2 + hstep, voffB);
            PG8_WAIT_V(6); PG8_BAR; PG8_MMA(1, 1, At, B1); PG8_BAR;
            PG8_LDB(B0, 1, 0); PG8_SCHED; PG8_LDA(At, 1, 0); PG8_STAGE(PG8_SA(0, 1), a2 + hstepA, voffA);
            PG8_WAIT_L(8); PG8_BAR; PG8_WAIT_L(0); PG8_MMA(0, 0, At, B0); PG8_BAR; PG8_SCHED;
            PG8_LDB(B1, 1, 1); PG8_STAGE(PG8_SB(1, 0), b3, voffB);
            PG8_BAR; PG8_WAIT_L(0); PG8_MMA(0, 1, At, B1); PG8_BAR;
            PG8_LDA(At, 1, 1); PG8_STAGE(PG8_SA(1, 0), a3, voffA);
            PG8_BAR; PG8_WAIT_L(0); PG8_MMA(1, 0, At, B0); PG8_BAR; PG8_SCHED;
            PG8_STAGE(PG8_SB(1, 1), b3 + hstep, voffB);
            PG8_WAIT_V(6); PG8_BAR; PG8_MMA(1, 1, At, B1); PG8_BAR;
            }
        }
        if constexpr (ALIGN_EPI) { if (wr == 0) PG8_BAR; }
        if constexpr (!Epi::AFTER_DRAIN) { E(acc, cur, wr, wc, fr, fq); S.done(cur); }
        if (!has_next) break;
#pragma unroll
        for (int a = 0; a < 2; ++a)
#pragma unroll
            for (int b = 0; b < 2; ++b)
#pragma unroll
                for (int m = 0; m < 4; ++m)
#pragma unroll
                    for (int n = 0; n < 2; ++n) acc[a][b][m][n] = (f32x4){0.f, 0.f, 0.f, 0.f};
        cur = nxt; cA = nA; cB = nB; ++ui;
        if constexpr (ALIGN_EPI) { if (wr == 1) PG8_BAR; }
    }
    PG8_WAIT_V(0);
    if constexpr (!ALIGN_EPI) { if (wr == 0) PG8_BAR; }
    PG8_BAR;
    if constexpr (Epi::AFTER_DRAIN) { E.fused(acc, cur, wr, wc, fr, fq, lds, wid, lane); S.done(cur); }
#undef PG8_SA
#undef PG8_SB
#undef PG8_STAGE
#undef PG8_LDA
#undef PG8_LDB
#undef PG8_MMA
#undef PG8_WAIT_V
#undef PG8_WAIT_L
#undef PG8_BAR
#undef PG8_SCHED
}
}

using pg8::bf16_t; using pg8::bf16x8; using pg8::f32x4; using pg8::u32x4; using pg8::Unit;
#define LAS __attribute__((address_space(3)))
#define GAS_ __attribute__((address_space(1)))
typedef LAS unsigned char* ldsp;
typedef float f32x16 __attribute__((ext_vector_type(16)));
typedef short s16x4 __attribute__((ext_vector_type(4)));
typedef float f32x2_t __attribute__((ext_vector_type(2)));
typedef __bf16 bf16x2_t __attribute__((ext_vector_type(2)));
typedef unsigned u32x2 __attribute__((ext_vector_type(2)));

constexpr int NB = 16, T = 4096, D = 1024, M = NB * T, FF = 2816;
constexpr int ZP0 = 2816, ZP1 = 3072;
constexpr int C_AQP = 0, C_AKC = 512, C_AVC = 640, C_AKS = 768, C_AVS = 896, C_AKW = 1024, C_AVW = 1152, C_BQ = 1280, C_BK = 1792, C_BV = 1920, C_GATE = 2048, C_AQR = 2304;
constexpr float LOG2E = 1.4426950408889634f;
constexpr float C2 = 0.125f * LOG2E;
constexpr float NORM_EPS = 1e-5f;
constexpr float NEG_INF = -__builtin_huge_valf();

constexpr size_t MiB = 1u << 20;
constexpr size_t WS_BAR = 1536 * 1024;
constexpr size_t WS_COS = 0, WS_SIN = 512 * 1024, WS_BIAS1 = 1 * MiB, WS_LSE = 2 * MiB, WS_HID = 6 * MiB, WS_KVC = 14 * MiB;
constexpr size_t W_IN = 22 * MiB, W_OUTE = W_IN + 2304ull * 1024 * 2, W_QKV = W_OUTE + 2 * MiB, W_OUTO = W_QKV + 6 * MiB, W_GU0 = W_OUTO + 2 * MiB, W_GU1 = W_GU0 + 11 * MiB,
                 W_DN0 = W_GU1 + 11 * MiB, W_DN1 = W_DN0 + 5632ull * 1024, W_W1 = W_DN1 + 5632ull * 1024, W_W2 = W_W1 + 2 * MiB, W_END = W_W2 + 256 * 1024;
static_assert(W_END <= 72 * MiB, "weights");
constexpr size_t WS_XN = 72 * MiB;
constexpr size_t WS_Z = 200 * MiB;
constexpr size_t WS_XB = 592 * MiB;
constexpr size_t WS_SS = 720 * MiB;
constexpr size_t WS_END = 724 * MiB;

constexpr int LDS_BYTES = 147456;
constexpr int LDS_WSF = 143360;
constexpr int LDS_BARST = 145472;
constexpr int LDS_NSA_RING = 65536, LDS_NSA_IMP = 98304, NSA_IMP_STRIDE = 4352;

struct Params { const float* in[17]; float* out; unsigned char* ws; float inv_freq[32]; };

#define LDS_WAIT() asm volatile("s_waitcnt lgkmcnt(0)" ::: "memory")
__device__ __forceinline__ unsigned f2bf(float f) { unsigned u = __builtin_bit_cast(unsigned, f); return (u + 0x7fffu + ((u >> 16) & 1u)) >> 16; }
__device__ __forceinline__ unsigned pk2(float lo, float hi) { f32x2_t v = {lo, hi}; bf16x2_t b = __builtin_convertvector(v, bf16x2_t); return __builtin_bit_cast(unsigned, b); }
__device__ __forceinline__ float bf2f(bf16_t v) { return __builtin_bit_cast(float, (unsigned)v << 16); }
__device__ __forceinline__ float wave_sum(float v) {
#pragma unroll
    for (int o = 1; o < 64; o <<= 1) v += __shfl_xor(v, o);
    return v;
}
__device__ __forceinline__ float fexp2(float x) { return __builtin_amdgcn_exp2f(x); }
__device__ __forceinline__ float silu_f(float g) { return g * __builtin_amdgcn_rcpf(1.0f + __expf(-g)); }
__device__ __forceinline__ float sigmoid_f(float g) { return __builtin_amdgcn_rcpf(1.0f + __expf(-g)); }


__device__ __forceinline__ void rows_rstd(float (&rs)[2][4], const float* SS, int row0, int fq) {
    f32x4 q[2][4];
#pragma unroll
    for (int ai = 0; ai < 2; ++ai)
#pragma unroll
        for (int m = 0; m < 4; ++m) q[ai][m] = *(const GAS_ f32x4*)(SS + (size_t)(row0 + ai * 128 + m * 16) * 16 + fq * 4);
#pragma unroll
    for (int ai = 0; ai < 2; ++ai)
#pragma unroll
        for (int m = 0; m < 4; ++m) { float s = (q[ai][m][0] + q[ai][m][1]) + (q[ai][m][2] + q[ai][m][3]); s += __shfl_xor(s, 16); s += __shfl_xor(s, 32);
            rs[ai][m] = 1.0f / sqrtf(s * (1.0f / 1024.0f) + 1e-5f); }
}
template <int HM> struct EpiZ {
    static constexpr bool PERM = true, AFTER_DRAIN = false;
    bf16_t* Z; int ldz; unsigned ropeMask, dualMask, scaleMask; int dualOff; const float* cosT; const float* sinT; const float* SS;
    __device__ __forceinline__ void operator()(const f32x4 (&acc)[2][2][4][2], const Unit& u, int wr, int wc, int fr, int fq) const {
        const int row0 = u.pm * 256 + wr * 64 + fr, col0 = u.pn * 256 + wc * 32 + 8 * fq, j0 = 16 * (wc & 1) + 4 * fq;
        float rsv[2][4];
        if (SS) rows_rstd(rsv, SS, row0, fq);
        const bool anyrope = ((ropeMask >> (2 * u.pn)) & 3u) != 0u;
#pragma unroll
        for (int ai = 0; ai < 2; ++ai) {
            f32x4 cc[4], ss[4];
            if (anyrope) {
#pragma unroll
                for (int m = 0; m < 4; ++m) { const int t = (row0 + ai * 128 + m * 16) & (T - 1); cc[m] = *(const GAS_ f32x4*)(cosT + t * 32 + j0); ss[m] = *(const GAS_ f32x4*)(sinT + t * 32 + j0); }
            }
            asm volatile("" ::: "memory");
#pragma unroll
            for (int m = 0; m < 4; ++m) {
                const int row = row0 + ai * 128 + m * 16;
                const f32x4 c4 = cc[m], s4 = ss[m];
                bf16_t* rowp = HM ? Z + ((size_t)(((row >> 12) * 3 + (col0 >> 10)) * 16 + ((col0 & 1023) >> 6)) * T + (row & (T - 1))) * 64 + (col0 & 63) : Z + (size_t)row * ldz + col0;
                constexpr int bjstep = HM ? 2 * T * 64 : 128;
                const float rs = SS ? rsv[ai][m] : 1.0f;
#pragma unroll
                for (int bj = 0; bj < 2; ++bj) {
                    const int h = u.pn * 2 + bj;
                    if (HM == 0 && col0 + bj * 128 >= 2072) continue;
                    const float sc = ((scaleMask >> h) & 1u) ? rs * C2 : rs;
                    f32x4 v0 = acc[ai][bj][m][0] * sc, v1 = acc[ai][bj][m][1] * sc;
                    int off = bj * bjstep;
                    if ((dualMask >> h) & 1u) { u32x4 w; w.x = pk2(v0[0], v0[1]); w.y = pk2(v0[2], v0[3]); w.z = pk2(v1[0], v1[1]); w.w = pk2(v1[2], v1[3]); *(GAS_ u32x4*)(rowp + off) = w; off += dualOff; }
                    if ((ropeMask >> h) & 1u) {
                        f32x4 a, b2;
                        a[0] = v0[0] * c4[0] - v0[1] * s4[0]; a[1] = v0[1] * c4[0] + v0[0] * s4[0];
                        a[2] = v0[2] * c4[1] - v0[3] * s4[1]; a[3] = v0[3] * c4[1] + v0[2] * s4[1];
                        b2[0] = v1[0] * c4[2] - v1[1] * s4[2]; b2[1] = v1[1] * c4[2] + v1[0] * s4[2];
                        b2[2] = v1[2] * c4[3] - v1[3] * s4[3]; b2[3] = v1[3] * c4[3] + v1[2] * s4[3];
                        v0 = a; v1 = b2;
                    }
                    u32x4 w; w.x = pk2(v0[0], v0[1]); w.y = pk2(v0[2], v0[3]); w.z = pk2(v1[0], v1[1]); w.w = pk2(v1[2], v1[3]);
                    *(GAS_ u32x4*)(rowp + off) = w;
                }
                asm volatile("" ::: "memory");
            }
        }
    }
};
struct EpiSwiglu {
    static constexpr bool PERM = true, AFTER_DRAIN = false;
    bf16_t* H; int ldh; const float* SS;
    __device__ __forceinline__ void operator()(const f32x4 (&acc)[2][2][4][2], const Unit& u, int wr, int wc, int fr, int fq) const {
        const int row0 = u.pm * 256 + wr * 64 + fr, hc0 = u.pn * 128 + wc * 32 + 8 * fq;
        float rsv[2][4];
        rows_rstd(rsv, SS, row0, fq);
#pragma unroll
        for (int ai = 0; ai < 2; ++ai)
#pragma unroll
            for (int m = 0; m < 4; ++m) {
                bf16_t* rowp = H + (size_t)(row0 + ai * 128 + m * 16) * ldh + hc0;
                const float rs = rsv[ai][m];
                const f32x4 g0 = acc[ai][0][m][0] * rs, g1 = acc[ai][0][m][1] * rs, u0 = acc[ai][1][m][0] * rs, u1 = acc[ai][1][m][1] * rs;
                u32x4 w; w.x = pk2(silu_f(g0[0]) * u0[0], silu_f(g0[1]) * u0[1]); w.y = pk2(silu_f(g0[2]) * u0[2], silu_f(g0[3]) * u0[3]);
                w.z = pk2(silu_f(g1[0]) * u1[0], silu_f(g1[1]) * u1[1]); w.w = pk2(silu_f(g1[2]) * u1[2], silu_f(g1[3]) * u1[3]);
                *(GAS_ u32x4*)rowp = w;
                asm volatile("" ::: "memory");
            }
    }
};
template <bool BASE_F32> struct EpiRes {
    static constexpr bool PERM = true, AFTER_DRAIN = false;
    const float* basef; bf16_t* XB; float* SS; int ldc;
    __device__ __forceinline__ void operator()(const f32x4 (&acc)[2][2][4][2], const Unit& u, int wr, int wc, int fr, int fq) const {
        const int row0 = u.pm * 256 + wr * 64 + fr, col0 = u.pn * 256 + wc * 32 + 8 * fq;
#pragma unroll
        for (int ai = 0; ai < 2; ++ai) {
            f32x4 bs[4][2][2]; u32x4 bh[4][2];
#pragma unroll
            for (int m = 0; m < 4; ++m) { const size_t off = (size_t)(row0 + ai * 128 + m * 16) * ldc + col0;
#pragma unroll
                for (int bj = 0; bj < 2; ++bj) {
                    if (BASE_F32) { bs[m][bj][0] = *(const GAS_ f32x4*)(basef + off + bj * 128); bs[m][bj][1] = *(const GAS_ f32x4*)(basef + off + bj * 128 + 4); }
                    else bh[m][bj] = *(const GAS_ u32x4*)(XB + off + bj * 128); } }
            asm volatile("" ::: "memory");
#pragma unroll
            for (int m = 0; m < 4; ++m) {
                const size_t off = (size_t)(row0 + ai * 128 + m * 16) * ldc + col0;
                float ssq = 0.f;
#pragma unroll
                for (int bj = 0; bj < 2; ++bj) {
                    f32x4 b0, b1;
                    if (BASE_F32) { b0 = bs[m][bj][0]; b1 = bs[m][bj][1]; }
                    else { const u32x4 h = bh[m][bj];
                        b0 = (f32x4){__builtin_bit_cast(float, h.x << 16), __builtin_bit_cast(float, h.x & 0xffff0000u), __builtin_bit_cast(float, h.y << 16), __builtin_bit_cast(float, h.y & 0xffff0000u)};
                        b1 = (f32x4){__builtin_bit_cast(float, h.z << 16), __builtin_bit_cast(float, h.z & 0xffff0000u), __builtin_bit_cast(float, h.w << 16), __builtin_bit_cast(float, h.w & 0xffff0000u)}; }
                    const f32x4 v0 = b0 + acc[ai][bj][m][0], v1 = b1 + acc[ai][bj][m][1];
                    ssq += ((v0[0] * v0[0] + v0[1] * v0[1]) + (v0[2] * v0[2] + v0[3] * v0[3])) + ((v1[0] * v1[0] + v1[1] * v1[1]) + (v1[2] * v1[2] + v1[3] * v1[3]));
                    u32x4 w; w.x = pk2(v0[0], v0[1]); w.y = pk2(v0[2], v0[3]); w.z = pk2(v1[0], v1[1]); w.w = pk2(v1[2], v1[3]); *(GAS_ u32x4*)(XB + off + bj * 128) = w;
                }
                ssq += __shfl_xor(ssq, 16); ssq += __shfl_xor(ssq, 32);
                if (fq == 0) *(GAS_ float*)(SS + (size_t)(row0 + ai * 128 + m * 16) * 16 + u.pn * 4 + wc) = ssq;
            }
            asm volatile("" ::: "memory");
        }
    }
};
template <int ACT> struct EpiB {
    static constexpr bool PERM = true, AFTER_DRAIN = false;
    bf16_t* O; int ldc; const float* bias;
    __device__ __forceinline__ void operator()(const f32x4 (&acc)[2][2][4][2], const Unit& u, int wr, int wc, int fr, int fq) const {
        const int row0 = u.pm * 256 + wr * 64 + fr, col0 = u.pn * 256 + wc * 32 + 8 * fq;
#pragma unroll
        for (int ai = 0; ai < 2; ++ai)
#pragma unroll
            for (int m = 0; m < 4; ++m) {
                bf16_t* rowp = O + (size_t)(row0 + ai * 128 + m * 16) * ldc + col0;
#pragma unroll
                for (int bj = 0; bj < 2; ++bj) {
                    f32x4 v0 = acc[ai][bj][m][0], v1 = acc[ai][bj][m][1];
                    if (bias) { v0 = v0 + *(const GAS_ f32x4*)(bias + col0 + bj * 128); v1 = v1 + *(const GAS_ f32x4*)(bias + col0 + bj * 128 + 4); }
                    if (ACT == 1) {
#pragma unroll
                        for (int e = 0; e < 4; ++e) { v0[e] = silu_f(v0[e]); v1[e] = silu_f(v1[e]); } }
                    u32x4 w; w.x = pk2(v0[0], v0[1]); w.y = pk2(v0[2], v0[3]); w.z = pk2(v1[0], v1[1]); w.w = pk2(v1[2], v1[3]);
                    *(GAS_ u32x4*)(rowp + bj * 128) = w;
                }
                asm volatile("" ::: "memory");
            }
    }
};
__device__ __forceinline__ int crow(int r, int hi) { return (r & 3) + 8 * (r >> 2) + 4 * hi; }
__device__ __forceinline__ float xh_max(float v) { auto rr = __builtin_amdgcn_permlane32_swap(__float_as_uint(v), __float_as_uint(v), false, false); return fmaxf(__uint_as_float(rr[0]), __uint_as_float(rr[1])); }
__device__ __forceinline__ float xh_sum(float v) { auto rr = __builtin_amdgcn_permlane32_swap(__float_as_uint(v), __float_as_uint(v), false, false); return __uint_as_float(rr[0]) + __uint_as_float(rr[1]); }
#define GAS __attribute__((address_space(1)))
__device__ __forceinline__ u32x4 ldg16(const bf16_t* p) { return *(const GAS u32x4*)p; }
__device__ __forceinline__ void tile_store(ldsp buf, const u32x4& k, const u32x4& v, int key, int ch) {
    *(LAS u32x4*)(buf + ch * 1024 + ((key ^ (2 * ch)) << 4)) = k;
    *(LAS u32x4*)(buf + 8192 + (ch >> 2) * 4096 + (key >> 4) * 1024 + (key & 15) * 64 + (ch & 3) * 16) = v;
}
__device__ __forceinline__ void q_load(bf16x8 (&qr)[4], const bf16_t* qrow, int hi) {
#pragma unroll
    for (int d0 = 0; d0 < 4; ++d0) qr[d0] = *(const GAS bf16x8*)(qrow + d0 * 16 + hi * 8);
}
__device__ __forceinline__ float max3f(float a, float b, float c) { float r; asm("v_max3_f32 %0, %1, %2, %3" : "=v"(r) : "v"(a), "v"(b), "v"(c)); return r; }
__device__ __forceinline__ void qk_tile(f32x16& p0, f32x16& p1, const ldsp Kt, const bf16x8 (&qr)[4], const f32x16& cin, int r32, int hi) {
    const ldsp kb = Kt + hi * 1024; const int ks = (r32 ^ (2 * hi)) << 4;
    __builtin_amdgcn_s_setprio(1);
#pragma unroll
    for (int d0 = 0; d0 < 4; ++d0) {
        const ldsp kp = kb + d0 * 2048 + (ks ^ (64 * d0));
        const bf16x8 b0 = *(const LAS bf16x8*)(kp), b1 = *(const LAS bf16x8*)(kp + 512);
        if (d0 == 0) { p0 = __builtin_amdgcn_mfma_f32_32x32x16_bf16(b0, qr[0], cin, 0, 0, 0); p1 = __builtin_amdgcn_mfma_f32_32x32x16_bf16(b1, qr[0], cin, 0, 0, 0); }
        else { p0 = __builtin_amdgcn_mfma_f32_32x32x16_bf16(b0, qr[d0], p0, 0, 0, 0); p1 = __builtin_amdgcn_mfma_f32_32x32x16_bf16(b1, qr[d0], p1, 0, 0, 0); }
    }
    __builtin_amdgcn_s_setprio(0);
    asm volatile("s_nop 15\n\ts_nop 7" : "+v"(p0), "+v"(p1));
}
__device__ __forceinline__ void mask_tile(f32x16& p0, f32x16& p1, int lo, int hq, int hi) {
    const bool nl = __any(lo > 0), nh = __any(hq < 63);
    if (nh && nl) {
#pragma unroll
        for (int r = 0; r < 16; ++r) { const int kk = crow(r, hi);
            if (!(kk >= lo && kk <= hq)) p0[r] = NEG_INF;
            if (!(kk + 32 >= lo && kk + 32 <= hq)) p1[r] = NEG_INF; }
    } else if (nh) {
        const int h2 = hq - 4 * hi;
#pragma unroll
        for (int r = 0; r < 16; ++r) { const int kc = (r & 3) + 8 * (r >> 2);
            if (kc > h2) p0[r] = NEG_INF;
            if (kc + 32 > h2) p1[r] = NEG_INF; }
    } else if (nl) {
        const int l2 = lo - 4 * hi;
#pragma unroll
        for (int r = 0; r < 16; ++r) { const int kc = (r & 3) + 8 * (r >> 2);
            if (kc < l2) p0[r] = NEG_INF;
            if (kc + 32 < l2) p1[r] = NEG_INF; }
    }
}
__device__ __forceinline__ float tile_max(const f32x16& p0, const f32x16& p1) {
    float a = max3f(p0[0], p0[1], p1[0]), b = max3f(p0[2], p0[3], p1[1]); a = max3f(a, p1[2], p1[3]);
#pragma unroll
    for (int r = 4; r < 16; r += 4) { a = max3f(a, p0[r], p0[r + 1]); b = max3f(b, p0[r + 2], p0[r + 3]); a = max3f(a, p1[r], p1[r + 1]); b = max3f(b, p1[r + 2], p1[r + 3]); }
    return xh_max(max3f(a, b, b));
}
__device__ __forceinline__ void splat16(f32x16& v, float x) {
#pragma unroll
    for (int r = 0; r < 16; ++r) v[r] = x;
    asm volatile("" : "+v"(v));
}
constexpr float SM_THR = 6.0f;
__device__ __forceinline__ void sm_update(f32x16& p0, f32x16& p1, float& mref, f32x16& negm, float& l, f32x16 (&o)[2], bool first, LAS float* wsf, int r32, int hi) {
    const float rm = tile_max(p0, p1);
    if (first || __any(rm > SM_THR)) {
        const float dl = first ? ((rm == NEG_INF) ? 0.f : rm) : fmaxf(rm, 0.f);
        mref += dl;
#pragma unroll
        for (int r = 0; r < 16; ++r) { p0[r] -= dl; p1[r] -= dl; }
        splat16(negm, -mref);
        if (!first) {
            const float f = fexp2(-dl);
            l *= f;
            if (hi == 0) wsf[r32] = f;
            LDS_WAIT();
#pragma unroll
            for (int r = 0; r < 16; ++r) { const float g = wsf[crow(r, hi)]; o[0][r] *= g; o[1][r] *= g; }
            LDS_WAIT();
        }
    }
    float s = 0.f;
#pragma unroll
    for (int r = 0; r < 16; ++r) { p0[r] = fexp2(p0[r]); p1[r] = fexp2(p1[r]); s += p0[r] + p1[r]; }
    l += s;
}
__device__ __forceinline__ s16x4 vtr(const ldsp p) { typedef short v4i16_t __attribute__((ext_vector_type(4))); return __builtin_bit_cast(s16x4, __builtin_amdgcn_ds_read_tr16_b64_v4i16((LAS v4i16_t*)p)); }
__device__ __forceinline__ void pv_tile(f32x16 (&o)[2], const ldsp Vt, const f32x16& p0, const f32x16& p1, int lane, int hi) {
    u32x4 pw[4];
    pw[0] = (u32x4){pk2(p0[0], p0[1]), pk2(p0[2], p0[3]), pk2(p0[4], p0[5]), pk2(p0[6], p0[7])};
    pw[1] = (u32x4){pk2(p0[8], p0[9]), pk2(p0[10], p0[11]), pk2(p0[12], p0[13]), pk2(p0[14], p0[15])};
    pw[2] = (u32x4){pk2(p1[0], p1[1]), pk2(p1[2], p1[3]), pk2(p1[4], p1[5]), pk2(p1[6], p1[7])};
    pw[3] = (u32x4){pk2(p1[8], p1[9]), pk2(p1[10], p1[11]), pk2(p1[12], p1[13]), pk2(p1[14], p1[15])};
    const ldsp vp = Vt + ((lane >> 4) & 1) * 32 + (lane & 3) * 8 + (4 * hi + ((lane & 15) >> 2)) * 64;
    __builtin_amdgcn_s_setprio(1);
#pragma unroll
    for (int d0 = 0; d0 < 2; ++d0)
#pragma unroll
        for (int ks = 0; ks < 4; ++ks) {
            const s16x4 lo = vtr(vp + d0 * 4096 + ks * 1024), hh = vtr(vp + d0 * 4096 + ks * 1024 + 512);
            const bf16x8 vf = (bf16x8){lo[0], lo[1], lo[2], lo[3], hh[0], hh[1], hh[2], hh[3]};
            o[d0] = __builtin_amdgcn_mfma_f32_32x32x16_bf16(__builtin_bit_cast(bf16x8, pw[ks]), vf, o[d0], 0, 0, 0);
        }
    __builtin_amdgcn_s_setprio(0);
}
__device__ __forceinline__ void attn_step(const ldsp Kt, const ldsp Vt, const bf16x8 (&qr)[4], f32x16 (&o)[2], float& mref, f32x16& negm, float& l, int lo, int hq, bool en, bool first, LAS float* wsf, int lane, int r32, int hi) {
    f32x16 p0, p1;
    qk_tile(p0, p1, Kt, qr, negm, r32, hi);
    if (!__all(en)) { const float pen = en ? 0.f : NEG_INF;
#pragma unroll
        for (int r = 0; r < 16; ++r) { p0[r] += pen; p1[r] += pen; } }
    mask_tile(p0, p1, lo, hq, hi);
    sm_update(p0, p1, mref, negm, l, o, first, wsf, r32, hi);
    pv_tile(o, Vt, p0, p1, lane, hi);
}
__device__ __forceinline__ void rows_axpy(f32x16 (&acc)[2], const f32x16 (&o)[2], float f, LAS float* wsf, int r32, int hi, bool init) {
    LDS_WAIT();
    if (hi == 0) wsf[r32] = f;
    LDS_WAIT();
#pragma unroll
    for (int r = 0; r < 16; ++r) { const float g = wsf[crow(r, hi)];
        if (init) { acc[0][r] = o[0][r] * g; acc[1][r] = o[1][r] * g; } else { acc[0][r] += o[0][r] * g; acc[1][r] += o[1][r] * g; } }
    LDS_WAIT();
}

template <class F> __device__ __forceinline__ void stage_store(const f32x16 (&ot)[2], ldsp lds, int w, int lane, int r32, int hi, F rowp) {
    LAS float* stg = (LAS float*)(lds + 65536 + w * 8704);
#pragma unroll
    for (int d0 = 0; d0 < 2; ++d0)
#pragma unroll
        for (int r = 0; r < 16; ++r) stg[crow(r, hi) * 68 + d0 * 32 + r32] = ot[d0][r];
    LDS_WAIT();
#pragma unroll
    for (int i = 0; i < 4; ++i) {
        const int row = i * 8 + (lane >> 3);
        const f32x4 x0 = *(const LAS f32x4*)(stg + row * 68 + (lane & 7) * 8), x1 = *(const LAS f32x4*)(stg + row * 68 + (lane & 7) * 8 + 4);
        u32x4 ow; ow.x = pk2(x0[0], x0[1]); ow.y = pk2(x0[2], x0[3]); ow.z = pk2(x1[0], x1[1]); ow.w = pk2(x1[2], x1[3]);
        *(GAS u32x4*)(rowp(row) + (lane & 7) * 8) = ow;
    }
    LDS_WAIT();
}

__device__ __forceinline__ void b_unit(const bf16_t* Z, bf16_t* MIX, const float* sinks, ldsp lds, int b, int kvh, int qb, unsigned& gt, int wave0) {
    int tid_; asm volatile("v_mbcnt_lo_u32_b32 %0, -1, 0\n\tv_mbcnt_hi_u32_b32 %0, -1, %0" : "=&v"(tid_)); tid_ += wave0 * 64; const int tid = tid_, lane = tid & 63, w = __builtin_amdgcn_readfirstlane(tid >> 6), r32 = lane & 31, hi = lane >> 5;
    const int g = r32 >> 3, qq = r32 & 7, tq = 64 * qb + 8 * w + qq, head = kvh * 4 + g, key = tid >> 3, ch = tid & 7;
    LAS float* wsf = (LAS float*)(lds + LDS_WSF) + w * 64;
    const size_t tok = (size_t)b * T + tq;
    bf16x8 qr[4]; q_load(qr, Z + tok * ZP0 + C_BQ + head * 64, hi);
    float m = *(const GAS float*)(sinks + head) * LOG2E, l = (hi == 0) ? 1.f : 0.f;
    f32x16 o[2], negm; splat16(negm, -m);
    splat16(o[0], 0.f); splat16(o[1], 0.f);
    const int n0 = qb >= 2 ? qb - 2 : 0;
    const bf16_t* kvp = Z + ((size_t)b * T + key) * ZP0 + kvh * 64 + ch * 8;
    u32x4 rk0 = ldg16(kvp + (size_t)(64 * n0) * ZP0 + C_BK), rv0 = ldg16(kvp + (size_t)(64 * n0) * ZP0 + C_BV), rk1 = rk0, rv1 = rv0;
    if (n0 + 1 <= qb) { rk1 = ldg16(kvp + (size_t)(64 * (n0 + 1)) * ZP0 + C_BK); rv1 = ldg16(kvp + (size_t)(64 * (n0 + 1)) * ZP0 + C_BV); }
    tile_store(lds + (gt & 1u) * 16384, rk0, rv0, key, ch);
    if (n0 + 2 <= qb) { rk0 = ldg16(kvp + (size_t)(64 * (n0 + 2)) * ZP0 + C_BK); rv0 = ldg16(kvp + (size_t)(64 * (n0 + 2)) * ZP0 + C_BV); }
    __syncthreads();
#define B_STEP(n, RK, RV) do { \
        const ldsp buf = lds + (gt & 1u) * 16384, nxt = lds + ((gt + 1u) & 1u) * 16384; \
        if ((n) < qb) tile_store(nxt, RK, RV, key, ch); \
        if ((n) + 3 <= qb) { RK = ldg16(kvp + (size_t)(64 * ((n) + 3)) * ZP0 + C_BK); RV = ldg16(kvp + (size_t)(64 * ((n) + 3)) * ZP0 + C_BV); } \
        attn_step(buf, buf + 8192, qr, o, m, negm, l, tq - 127 - 64 * (n), tq - 64 * (n), true, false, wsf, lane, r32, hi); \
        __syncthreads(); ++gt; } while (0)
    for (int n = n0; n <= qb; n += 2) { B_STEP(n, rk1, rv1); if (n + 1 <= qb) B_STEP(n + 1, rk0, rv0); }
#undef B_STEP
    const float lt = xh_sum(l);
    f32x16 ot[2];
    rows_axpy(ot, o, 1.0f / lt, wsf, r32, hi, true);
    stage_store(ot, lds, w, lane, r32, hi, [=](int q) { return MIX + ((size_t)b * T + 64 * qb + 8 * w + (q & 7)) * 1024 + 512 + (kvh * 4 + (q >> 3)) * 64; });
}

__device__ __forceinline__ void nsa_unit(const bf16_t* Z, const bf16_t* KVC, bf16_t* MIX, ldsp lds, int b, int kvh, int qb, unsigned& gt, int wave0) {
    int tid_; asm volatile("v_mbcnt_lo_u32_b32 %0, -1, 0\n\tv_mbcnt_hi_u32_b32 %0, -1, %0" : "=&v"(tid_)); tid_ += wave0 * 64; const int tid = tid_, lane = tid & 63, w = __builtin_amdgcn_readfirstlane(tid >> 6), r32 = lane & 31, hi = lane >> 5;
    const int g = r32 >> 3, qq = r32 & 7, tq = 64 * qb + 8 * w + qq, head = kvh * 4 + g, key = tid >> 3, ch = tid & 7;
    LAS float* wsf = (LAS float*)(lds + LDS_WSF) + w * 64;
    const size_t tok = (size_t)b * T + tq;
    const bf16_t* zrow = Z + tok * ZP0;
    const int nct = (4 * qb + 3 + 63) >> 6;
    {
        const bf16_t* kv = KVC + ((size_t)(b * 2 + kvh) * 256 + key) * 512 + ch * 8;
        for (int ct = 0; ct < nct; ++ct) { const u32x4 k = ldg16(kv + (size_t)ct * 64 * 512), v = ldg16(kv + (size_t)ct * 64 * 512 + 256); tile_store(lds + ct * 16384, k, v, key, ch); }
    }
    const GAS bf16_t* zg = (const GAS bf16_t*)(zrow + C_GATE + head * 3);
    const unsigned gpk = (unsigned)zg[0] | ((unsigned)zg[1] << 16), gp2 = (unsigned)zg[2];
#define GATE0() sigmoid_f(__builtin_bit_cast(float, gpk << 16))
#define GATE1() sigmoid_f(__builtin_bit_cast(float, gpk & 0xffff0000u))
#define GATE2() sigmoid_f(__builtin_bit_cast(float, gp2 << 16))
    bf16x8 qr[4]; q_load(qr, zrow + C_AQP + head * 64, hi);
    __syncthreads();
    float m = 0.f, l = 0.f;
    f32x16 o[2], ot[2], negm; splat16(negm, 0.f);
    splat16(o[0], 0.f); splat16(o[1], 0.f);
    const int cmax = (tq - 31) >> 4;
    for (int ct = 0; ct < nct; ++ct) attn_step(lds + ct * 16384, lds + ct * 16384 + 8192, qr, o, m, negm, l, 0, cmax - 64 * ct, true, ct == 0, wsf, lane, r32, hi);
    const float ltc = xh_sum(l), inv = ltc > 0.f ? 1.0f / ltc : 0.f;
    unsigned long long selmask = ~0ull;
    if (qb >= 16) {
        LAS float* G = (LAS float*)(lds + LDS_NSA_IMP + w * NSA_IMP_STRIDE); LAS float* L = G + 512;
        for (int ct = 0; ct < nct; ++ct) {
            f32x16 p0, p1;
            qk_tile(p0, p1, lds + ct * 16384, qr, negm, r32, hi);
            mask_tile(p0, p1, 0, cmax - 64 * ct, hi);
#pragma unroll
            for (int r = 0; r < 16; ++r) { p0[r] = fexp2(p0[r]) * inv; p1[r] = fexp2(p1[r]) * inv; }
#pragma unroll
            for (int hf = 0; hf < 2; ++hf)
#pragma unroll
                for (int grp = 0; grp < 4; ++grp) {
                    float gs, ls;
                    if (hf == 0) { gs = (p0[4 * grp] + p0[4 * grp + 1]) + (p0[4 * grp + 2] + p0[4 * grp + 3]); ls = p0[4 * grp + 3]; }
                    else         { gs = (p1[4 * grp] + p1[4 * grp + 1]) + (p1[4 * grp + 2] + p1[4 * grp + 3]); ls = p1[4 * grp + 3]; }
                    gs += __shfl_xor(gs, 8); gs += __shfl_xor(gs, 16); ls += __shfl_xor(ls, 8); ls += __shfl_xor(ls, 16);
                    const int n = ct * 16 + hf * 8 + 2 * grp + hi;
                    if (g == 0) { G[qq * 64 + n] = gs; L[qq * 68 + n + 1] = ls; }
                }
        }
        LDS_WAIT();
#pragma unroll 1
        for (int q8 = 0; q8 < 8; ++q8) {
            float v = G[q8 * 64 + lane] + (lane > 0 ? L[q8 * 68 + lane] : 0.f);
            v = (lane > qb) ? -1.f : v;
            v = (lane == 0) ? 3e38f : (lane == qb) ? 2e38f : (lane == qb - 1) ? 1e38f : v;
            int rank = 0;
#pragma unroll
            for (int j = 0; j < 64; ++j) { const float vj = __uint_as_float(__builtin_amdgcn_readlane(__float_as_uint(v), j)); rank += (vj > v) ? 1 : 0; }
            const unsigned long long mk = __ballot(rank < 16);
            if (qq == q8) selmask = mk;
        }
    }
    rows_axpy(ot, o, GATE0() * inv, wsf, r32, hi, true);
    q_load(qr, zrow + C_AQR + head * 64, hi);
    const int ns = qb + 1, w0 = qb >= 8 ? qb - 8 : 0, ntile = ns + (qb - w0 + 1);
    m = 0.f; l = 0.f; splat16(negm, 0.f);
    splat16(o[0], 0.f); splat16(o[1], 0.f);
    const bf16_t* kvp = Z + ((size_t)b * T + key) * ZP0 + kvh * 64 + ch * 8;
#define NSA_LOAD(j, RK, RV) do { const bool nw_ = (j) >= ns; const int nn_ = nw_ ? w0 + (j) - ns : (j); \
        RK = ldg16(kvp + (size_t)(64 * nn_) * ZP0 + (nw_ ? C_AKW : C_AKS)); RV = ldg16(kvp + (size_t)(64 * nn_) * ZP0 + (nw_ ? C_AVW : C_AVS)); } while (0)
    u32x4 rk0, rv0, rk1, rv1;
    NSA_LOAD(0, rk0, rv0); NSA_LOAD(1, rk1, rv1);
    tile_store(lds + LDS_NSA_RING + (gt & 1u) * 16384, rk0, rv0, key, ch);
    if (2 < ntile) NSA_LOAD(2, rk0, rv0);
    __syncthreads();
    LAS float* slab = (LAS float*)(lds + w * 8192) + lane;
#pragma unroll
    for (int k = 0; k < 16; ++k) { slab[k * 64] = ot[0][k]; slab[(16 + k) * 64] = ot[1][k]; }
#define NSA_STEP(i, RK, RV) do { \
        const bool isw = (i) >= ns; const int n = isw ? w0 + (i) - ns : (i); \
        const ldsp buf = lds + LDS_NSA_RING + (gt & 1u) * 16384, nxt = lds + LDS_NSA_RING + ((gt + 1u) & 1u) * 16384; \
        if ((i) + 1 < ntile) tile_store(nxt, RK, RV, key, ch); \
        if ((i) + 3 < ntile) NSA_LOAD((i) + 3, RK, RV); \
        if ((i) == ns) { \
            const float lt = xh_sum(l); f32x16 t2[2]; \
            rows_axpy(t2, o, GATE1() / lt, wsf, r32, hi, true); \
            _Pragma("unroll") for (int k = 0; k < 16; ++k) { slab[k * 64] += t2[0][k]; slab[(16 + k) * 64] += t2[1][k]; } \
            m = 0.f; l = 0.f; splat16(negm, 0.f); \
            splat16(o[0], 0.f); splat16(o[1], 0.f); \
        } \
        const bool en = isw ? true : (((selmask >> n) & 1ull) != 0ull); \
        const int lo = isw ? tq - 511 - 64 * n : 0, hq = tq - 64 * n; \
        if (__any(en)) attn_step(buf, buf + 8192, qr, o, m, negm, l, lo, hq, en, (i) == 0 || (i) == ns, wsf, lane, r32, hi); \
        __syncthreads(); ++gt; } while (0)
    for (int i = 0; i < ntile; i += 2) { NSA_STEP(i, rk1, rv1); if (i + 1 < ntile) NSA_STEP(i + 1, rk0, rv0); }
#undef NSA_STEP
#undef NSA_LOAD
    {
        const float lt = xh_sum(l);
        rows_axpy(ot, o, GATE2() / lt, wsf, r32, hi, true);
#pragma unroll
        for (int k = 0; k < 16; ++k) { ot[0][k] += slab[k * 64]; ot[1][k] += slab[(16 + k) * 64]; }
    }
    stage_store(ot, lds, w, lane, r32, hi, [=](int q) { return MIX + ((size_t)b * T + 64 * qb + 8 * w + (q & 7)) * 1024 + (kvh * 4 + (q >> 3)) * 64; });
    __syncthreads();
#undef GATE0
#undef GATE1
#undef GATE2
}

__device__ __forceinline__ void c_phase(const bf16_t* Z, bf16_t* MIX, float* LSE, ldsp lds, int pi, int bx, int G, unsigned& gt, int wave0, int ucount) {
    int tid_; asm volatile("v_mbcnt_lo_u32_b32 %0, -1, 0\n\tv_mbcnt_hi_u32_b32 %0, -1, %0" : "=&v"(tid_)); tid_ += wave0 * 64; const int tid = tid_, lane = tid & 63, w = __builtin_amdgcn_readfirstlane(tid >> 6), r32 = lane & 31, hi = lane >> 5;
    const int hsel = w >> 2, gq = (w < 4) ? w : 7 - w, key = tid >> 3, ch = tid & 7;
    const int ldil = 2 * pi, dil = 1 << ldil, lnb = 5 - ldil;
    LAS float* wsf = (LAS float*)(lds + LDS_WSF) + w * 64;
    const size_t tstride = (size_t)64 * dil * 64;
    const unsigned kvlane = (unsigned)(key * dil * 64 + ch * 8), qlane = (unsigned)(r32 * dil * 64), olane = (unsigned)((lane >> 3) * dil * 1024 + (lane & 7) * 8), llane = (unsigned)(r32 * dil * 16);
#define C_DEC(u_, b_, hp_, rs_, blk_) const int blk_ = (u_) & ((1 << lnb) - 1), rs_ = ((u_) >> lnb) & (dil - 1), hp_ = ((u_) >> 5) & 7, b_ = (u_) >> 8
#define C_KVP(b_, hp_, rs_) (Z + ((size_t)(((b_) * 3 + 1) * 16 + 2 * (hp_)) * T + (rs_)) * 64)
#define C_QROW(b_, hp_, rs_, blk_) (Z + ((size_t)(((b_) * 3) * 16 + 2 * (hp_) + hsel) * T + (size_t)(128 * (blk_) + 32 * gq) * dil + (rs_)) * 64 + qlane)
#define C_LOADP(p_) do { const bf16_t* q_ = (p_); rka = ldg16(q_ + kvlane); rva = ldg16(q_ + (size_t)16 * T * 64 + kvlane); rkb = ldg16(q_ + (size_t)T * 64 + kvlane); rvb = ldg16(q_ + (size_t)17 * T * 64 + kvlane); } while (0)
    const u32x4 z4 = {0u, 0u, 0u, 0u};
    u32x4 rka = z4, rva = z4, rkb = z4, rvb = z4;
    const int per = (ucount + G - 1) / G, uend = (bx + 1) * per < ucount ? (bx + 1) * per : ucount;
    int u = bx * per;
    if (u >= uend) return;
    {   C_DEC(u, b, hp, rs, blk); const int kt0 = blk >= 1 ? 2 * blk - 2 : 0; const bf16_t* kvp = C_KVP(b, hp, rs);
        C_LOADP(kvp + kt0 * tstride);
        { const ldsp b0 = lds + (gt & 1u) * 32768; tile_store(b0, rka, rva, key, ch); tile_store(b0 + 16384, rkb, rvb, key, ch); }
        C_LOADP(kvp + (kt0 + 1) * tstride);
        __syncthreads(); }
    for (; u < uend; ++u) {
        C_DEC(u, b, hp, rs, blk);
        const int head = 2 * hp + hsel, q0 = 128 * blk + 32 * gq, ql = q0 + r32;
        const int kt0 = blk >= 1 ? 2 * blk - 2 : 0, kt1 = 2 * blk + 1;
        const bf16_t* kvp = C_KVP(b, hp, rs);
        const bool has_next = u + 1 < uend;
        const int un = has_next ? u + 1 : u;
        C_DEC(un, bn, hpn, rsn, blkn);
        const int kt0n = blkn >= 1 ? 2 * blkn - 2 : 0;
        const bf16_t* kvpn = C_KVP(bn, hpn, rsn) + kt0n * tstride;
        bf16x8 qr[4]; q_load(qr, C_QROW(b, hp, rs, blk), hi);
        GAS float* lsep = (GAS float*)(LSE + ((size_t)b * T + (size_t)q0 * dil + rs) * 16 + head + llane);
        bf16_t* orow = MIX + ((size_t)b * T + (size_t)q0 * dil + rs) * 1024 + head * 64 + olane;
        const size_t ostep = (size_t)8 * dil * 1024;
        u32x4 orun[4] = {z4, z4, z4, z4}; float lse_old = 0.f;
        float m = 0.f, l = 0.f; bool started = false;
        f32x16 o[2], negm; splat16(negm, 0.f);
        splat16(o[0], 0.f); splat16(o[1], 0.f);
        for (int kt = kt0; kt <= kt1; ++kt) {
            const ldsp buf = lds + (gt & 1u) * 32768, nxt = lds + ((gt + 1u) & 1u) * 32768;
            if (kt == kt1 - 1) {
                if (pi > 0) { lse_old = *lsep;
#pragma unroll
                    for (int i = 0; i < 4; ++i) orun[i] = ldg16(orow + i * ostep); }
            }
            if (64 * kt <= q0 + 31 && 64 * kt + 63 >= q0 - 128) {
                attn_step(buf + hsel * 16384, buf + hsel * 16384 + 8192, qr, o, m, negm, l, ql - 128 - 64 * kt, ql - 64 * kt, true, !started, wsf, lane, r32, hi); started = true; }
            if (kt < kt1 || has_next) { tile_store(nxt, rka, rva, key, ch); tile_store(nxt + 16384, rkb, rvb, key, ch); }
            if (kt + 2 <= kt1) C_LOADP(kvp + (kt + 2) * tstride);
            else if (has_next) { if (kt == kt1 - 1) C_LOADP(kvpn); else C_LOADP(kvpn + tstride); }
            __syncthreads(); ++gt;
        }
        const float lt = xh_sum(l), lse = m + __log2f(lt);
        float wa = 0.f, wb = 1.0f / lt;
        if (pi > 0) {
            const float mx = fmaxf(lse_old, lse), nl = mx + __log2f(fexp2(lse_old - mx) + fexp2(lse - mx));
            wa = fexp2(lse_old - nl); wb = fexp2(lse - nl) / lt;
            if (pi < 2 && hi == 0) *lsep = nl;
        } else if (hi == 0) *lsep = lse;
        LDS_WAIT();
        if (hi == 0) { wsf[r32] = wa; wsf[32 + r32] = wb; }
        LDS_WAIT();
        LAS float* stg = (LAS float*)(lds + 65536 + w * 8704);
#pragma unroll
        for (int d0 = 0; d0 < 2; ++d0)
#pragma unroll
            for (int r = 0; r < 16; ++r) { const int q = crow(r, hi); stg[q * 68 + d0 * 32 + r32] = wsf[32 + q] * o[d0][r]; }
        LDS_WAIT();
#pragma unroll
        for (int i = 0; i < 4; ++i) {
            const int row = i * 8 + (lane >> 3);
            const f32x4 x0 = *(const LAS f32x4*)(stg + row * 68 + (lane & 7) * 8), x1 = *(const LAS f32x4*)(stg + row * 68 + (lane & 7) * 8 + 4);
            float v[8] = {x0[0], x0[1], x0[2], x0[3], x1[0], x1[1], x1[2], x1[3]};
            if (pi > 0) { const float fa = wsf[row];
#pragma unroll
                for (int k = 0; k < 4; ++k) { const unsigned wd = orun[i][k]; v[2 * k] += fa * __builtin_bit_cast(float, wd << 16); v[2 * k + 1] += fa * __builtin_bit_cast(float, wd & 0xffff0000u); } }
            u32x4 ow; ow.x = pk2(v[0], v[1]); ow.y = pk2(v[2], v[3]); ow.z = pk2(v[4], v[5]); ow.w = pk2(v[6], v[7]);
            *(GAS u32x4*)(orow + i * ostep) = ow;
        }
        LDS_WAIT();
    }
#undef C_DEC
#undef C_KVP
#undef C_QROW
#undef C_LOADP
}
__device__ __forceinline__ int il64(int p) { return (p & 1) ? (p >> 1) + 32 : (p >> 1); }
__device__ __forceinline__ int src_col(int mapid, int n) {
    switch (mapid) {
    case 0:
        if (n < 512) return (n & ~63) + il64(n & 63);
        if (n < 768) return n;
        if (n < 896) return (n & ~63) + il64(n & 63);
        if (n < 1024) return n;
        if (n < 1152) return (n & ~63) + il64(n & 63);
        if (n < 1280) return n;
        if (n < 1792) { const int q = n - 1280; return 1304 + (q & ~63) + il64(q & 63); }
        if (n < 1920) { const int q = n - 1792; return 1816 + (q & ~63) + il64(q & 63); }
        if (n < 2048) return 1944 + (n - 1920);
        if (n < 2072) return 1280 + (n - 2048);
        return -1;
    case 2: return n < 2048 ? (n & ~63) + il64(n & 63) : n;
    case 3: { const int hid = (n >> 8) * 128 + (n & 127); return ((n >> 7) & 1) ? FF + hid : hid; }
    case 4: return n < 64 ? il64(n) : -1;
    case 5: return n < 64 ? n : -1;
    default: return n;
    }
}
__device__ __forceinline__ void tr_item(const float* W, int K, int Nlog, const float* gain, bf16_t* Wt, int mapid, int nblk, LAS float* scr, int item, int lane) {
    const int kb = item / nblk, nb = item % nblk, k0 = 64 * kb, n0 = 32 * nb;
    const int src = src_col(mapid, n0 + (lane & 31));
#pragma unroll
    for (int i = 0; i < 32; ++i) { const int kk = 2 * i + (lane >> 5); float v = 0.f;
        if (src >= 0) { v = *(const GAS float*)(W + (size_t)(k0 + kk) * Nlog + src); if (gain) v *= *(const GAS float*)(gain + k0 + kk); }
        scr[kk * 33 + (lane & 31)] = v; }
    LDS_WAIT();
    const int c = lane & 7;
#pragma unroll
    for (int j = 0; j < 4; ++j) { const int n = (lane >> 3) + 8 * j; const LAS float* s = scr + (8 * c) * 33 + n;
        u32x4 o; o.x = pk2(s[0 * 33], s[1 * 33]); o.y = pk2(s[2 * 33], s[3 * 33]); o.z = pk2(s[4 * 33], s[5 * 33]); o.w = pk2(s[6 * 33], s[7 * 33]);
        *(GAS u32x4*)(Wt + (size_t)(n0 + n) * K + k0 + 8 * c) = o; }
    LDS_WAIT();
}
__device__ __forceinline__ void row_to_bf16_ss(const float* xrow, bf16_t* orow, float* ssrow, int lane) {
    const GAS f32x4* xr = (const GAS f32x4*)xrow + 2 * lane;
    f32x4 v[4]; float s = 0.f;
#pragma unroll
    for (int j = 0; j < 2; ++j) { v[2 * j] = xr[128 * j]; v[2 * j + 1] = xr[128 * j + 1]; }
#pragma unroll
    for (int j = 0; j < 4; ++j) s += (v[j].x * v[j].x + v[j].y * v[j].y) + (v[j].z * v[j].z + v[j].w * v[j].w);
    s = wave_sum(s);
    GAS u32x4* o16 = (GAS u32x4*)orow + lane;
#pragma unroll
    for (int j = 0; j < 2; ++j) { u32x4 w; w.x = pk2(v[2 * j].x, v[2 * j].y); w.y = pk2(v[2 * j].z, v[2 * j].w); w.z = pk2(v[2 * j + 1].x, v[2 * j + 1].y); w.w = pk2(v[2 * j + 1].z, v[2 * j + 1].w); o16[64 * j] = w; }
    if (lane < 16) *(GAS float*)(ssrow + lane) = (lane == 0) ? s : 0.f;
}
__device__ __forceinline__ void rms_row_final(const bf16_t* xbrow, float* orow, const float* gain, const float* ssrow, int lane) {
    GAS f32x4* xo = (GAS f32x4*)orow + 2 * lane; const GAS f32x4* gr = (const GAS f32x4*)gain + 2 * lane; const GAS u32x4* xr = (const GAS u32x4*)xbrow + lane;
    u32x4 h[2];
#pragma unroll
    for (int j = 0; j < 2; ++j) h[j] = xr[64 * j];
    const float s = lane < 16 ? *(const GAS float*)(ssrow + lane) : 0.f;
    const float rstd = 1.0f / sqrtf(wave_sum(s) * (1.0f / D) + NORM_EPS);
#pragma unroll
    for (int j = 0; j < 2; ++j) {
        const f32x4 a = (f32x4){__builtin_bit_cast(float, h[j].x << 16), __builtin_bit_cast(float, h[j].x & 0xffff0000u), __builtin_bit_cast(float, h[j].y << 16), __builtin_bit_cast(float, h[j].y & 0xffff0000u)};
        const f32x4 b = (f32x4){__builtin_bit_cast(float, h[j].z << 16), __builtin_bit_cast(float, h[j].z & 0xffff0000u), __builtin_bit_cast(float, h[j].w << 16), __builtin_bit_cast(float, h[j].w & 0xffff0000u)};
        xo[128 * j] = (a * rstd) * gr[128 * j]; xo[128 * j + 1] = (b * rstd) * gr[128 * j + 1]; }
}
__device__ __forceinline__ void sincos_d(float a, float& c, float& s) {
    const double x = (double)a; const double kq = __builtin_rint(x * 0.63661977236758134308);
    double r = __builtin_fma(-kq, 1.57079632679489655800, x); r = __builtin_fma(-kq, 6.12323399573676603587e-17, r);
    const double r2 = r * r;
    const double sn = r * (1.0 + r2 * (-1.0 / 6 + r2 * (1.0 / 120 + r2 * (-1.0 / 5040 + r2 * (1.0 / 362880 + r2 * (-1.0 / 39916800 + r2 * (1.0 / 6227020800.0)))))));
    const double cs = 1.0 + r2 * (-0.5 + r2 * (1.0 / 24 + r2 * (-1.0 / 720 + r2 * (1.0 / 40320 + r2 * (-1.0 / 3628800 + r2 * (1.0 / 479001600.0 + r2 * (-1.0 / 87178291200.0)))))));
    const int q = (int)kq & 3;
    const double so = (q == 0) ? sn : (q == 1) ? cs : (q == 2) ? -sn : -cs, co = (q == 0) ? cs : (q == 1) ? -sn : (q == 2) ? -cs : sn;
    c = (float)co; s = (float)so;
}

typedef unsigned v4u __attribute__((ext_vector_type(4)));
#define XB_TMO      128
#define XB_XCNT(j)  (256  + 64 * (j))
#define XB_XSUB(j)  (1280 + 64 * (j))
#define XB_XGEN(j)  (2304 + 64 * (j))
#define XB_TOP      3328
#define XB_TOPGEN   3392
#define XCD_BAR_WORDS 3456
#define XB_SPIN_CAP (1u << 18)

__device__ __forceinline__ unsigned xb_ld(unsigned* p)              { return __hip_atomic_load(p, __ATOMIC_RELAXED, __HIP_MEMORY_SCOPE_AGENT); }
__device__ __forceinline__ unsigned xb_add(unsigned* p, unsigned v) { return __hip_atomic_fetch_add(p, v, __ATOMIC_RELAXED, __HIP_MEMORY_SCOPE_AGENT); }
__device__ __forceinline__ unsigned xb_xcc_id() { return (unsigned)__builtin_amdgcn_s_getreg((3 << 11) | 20) & 0xFu; }
#define XB_SPIN(cond, bar) do { unsigned _sp = 0; while (cond) { __builtin_amdgcn_s_sleep(1); \
    if ((++_sp & 255u) == 0u) { if (xb_ld(&(bar)[XB_TMO])) break; if (_sp > XB_SPIN_CAP) { atomicAdd(&(bar)[XB_TMO], 1u); break; } } } } while (0)

struct XcdBarrier {
    unsigned* bar; unsigned x; int w0;
    volatile LAS unsigned* st;
};

__device__ __forceinline__ bool xb_thread0(int w0) { return w0 == 0 && __builtin_amdgcn_mbcnt_hi(~0u, __builtin_amdgcn_mbcnt_lo(~0u, 0u)) == 0u; }
__device__ __forceinline__ XcdBarrier xcd_barrier_post(unsigned* bar, volatile LAS unsigned* st, int w0) {
    XcdBarrier b; b.bar = bar; b.x = xb_xcc_id(); b.st = st; b.w0 = w0;
    if (xb_thread0(w0)) (void)xb_add(&bar[XB_XCNT(b.x)], 1u);
    return b;
}
__device__ __forceinline__ void xcd_barrier_complete(unsigned* bar, unsigned x, unsigned& nloc, unsigned& nx) {
    const unsigned G = gridDim.x * gridDim.y * gridDim.z;
    unsigned sum, cnt, mine, sp = 0u;
    for (;;) {
        sum = 0u; cnt = 0u; mine = 0u;
#pragma unroll
        for (unsigned j = 0; j < 16; ++j) { const unsigned c = xb_ld(&bar[XB_XCNT(j)]); sum += c; cnt += (c > 0u) ? 1u : 0u; mine = (j == x) ? c : mine; }
        if (sum == G) break;
        __builtin_amdgcn_s_sleep(1);
        if ((++sp & 255u) == 0u) { if (xb_ld(&bar[XB_TMO])) break; if (sp > XB_SPIN_CAP) { atomicAdd(&bar[XB_TMO], 1u); break; } }
    }
    nloc = mine > 0u ? mine : 1u; nx = cnt > 0u ? cnt : 1u;
}

__device__ __forceinline__ void xcd_barrier(const XcdBarrier& b) {
    asm volatile("s_waitcnt vmcnt(0)" ::: "memory");
    __syncthreads();
    if (xb_thread0(b.w0)) {
        unsigned* bar = b.bar;
        __builtin_amdgcn_s_waitcnt(0);
        unsigned nloc = b.st[0], nx = b.st[1];
        if (nloc == 0u) { xcd_barrier_complete(bar, b.x, nloc, nx); b.st[0] = nloc; b.st[1] = nx; }
        const unsigned old = xb_add(&bar[XB_XSUB(b.x)], 1u);
        const unsigned gen = old / nloc;
        if (old + 1u == (gen + 1u) * nloc) {
            __builtin_amdgcn_fence(__ATOMIC_RELEASE, "agent");
            asm volatile("s_waitcnt vmcnt(0)" ::: "memory");
            const unsigned og = xb_add(&bar[XB_TOP], 1u);
            const unsigned tg = og / nx;
            if (og + 1u == (tg + 1u) * nx) xb_add(&bar[XB_TOPGEN], 1u);
            else XB_SPIN(xb_ld(&bar[XB_TOPGEN]) == tg, bar);
            __builtin_amdgcn_fence(__ATOMIC_ACQUIRE, "agent");
            xb_add(&bar[XB_XGEN(b.x)], 1u);
            asm volatile("s_waitcnt vmcnt(0)" ::: "memory");
        } else {
            XB_SPIN(xb_ld(&bar[XB_XGEN(b.x)]) == gen, bar);
            __builtin_amdgcn_fence(__ATOMIC_ACQUIRE, "agent");
            asm volatile("s_waitcnt vmcnt(0)" ::: "memory");
        }
    }
    __syncthreads();
}

__global__ void __launch_bounds__(512, 2) fwd_mega(Params P) {
    extern __shared__ __attribute__((aligned(16))) unsigned char lds_raw[];
    cg::grid_group grid = cg::this_grid();
    const ldsp lds = (ldsp)lds_raw;
    const int G = gridDim.x, bx = blockIdx.x, NGW = G * 8;
    const int wave0 = __builtin_amdgcn_readfirstlane((int)threadIdx.x >> 6);
#define TID_SETUP() int tid_; asm volatile("v_mbcnt_lo_u32_b32 %0, -1, 0\n\tv_mbcnt_hi_u32_b32 %0, -1, %0" : "=&v"(tid_)); tid_ += wave0 * 64; const int tid = tid_, lane = tid & 63, wave = __builtin_amdgcn_readfirstlane(tid >> 6), gw = bx * 8 + wave; (void)lane; (void)gw
#define WS_SETUP() unsigned char* ws = P.ws; asm volatile("" : "+s"(ws)); \
    float* cosT = (float*)(ws + WS_COS); float* sinT = (float*)(ws + WS_SIN); float* bias1 = (float*)(ws + WS_BIAS1); float* LSE = (float*)(ws + WS_LSE); \
    bf16_t* HID = (bf16_t*)(ws + WS_HID); bf16_t* KVC = (bf16_t*)(ws + WS_KVC); bf16_t* XN = (bf16_t*)(ws + WS_XN); bf16_t* MIX = XN; bf16_t* Z = (bf16_t*)(ws + WS_Z); bf16_t* H = Z; float* X = P.out; bf16_t* XB = (bf16_t*)(ws + WS_XB); float* SS = (float*)(ws + WS_SS); (void)XB; (void)SS; \
    (void)cosT; (void)sinT; (void)bias1; (void)LSE; (void)HID; (void)KVC; (void)XN; (void)MIX; (void)Z; (void)H; (void)X
    unsigned gt = 0;
    unsigned* barw = (unsigned*)(P.ws + WS_BAR);
    volatile LAS unsigned* barst = (volatile LAS unsigned*)(lds + LDS_BARST);
    { TID_SETUP();
    if (tid == 0) { barst[0] = 0u; barst[1] = 0u; }
    if (bx == 0) { for (int i = tid; i < XCD_BAR_WORDS; i += 512) __hip_atomic_store(barw + i, 0u, __ATOMIC_RELAXED, __HIP_MEMORY_SCOPE_AGENT); } }
    __syncthreads();

    {
        TID_SETUP(); WS_SETUP();
        LAS float* scr = (LAS float*)(lds + wave * 8704);
        constexpr int I0 = 16 * 72, I1 = 16 * 32, I2 = 16 * 96, I3 = 16 * 32, I4 = 16 * 176, I6 = 44 * 32, I8 = 32 * 8, I10 = 4 * 8;
        constexpr int NIT = I0 + I1 + I2 + I3 + 2 * I4 + 2 * I6 + 2 * I8 + 2 * I10;
        for (int it = gw; it < NIT; it += NGW) {
            int r = it;
            if (r < I0) { tr_item(P.in[4], 1024, 2072, P.in[1], (bf16_t*)(ws + W_IN), 0, 72, scr, r, lane); continue; } r -= I0;
            if (r < I1) { tr_item(P.in[5], 1024, 1024, nullptr, (bf16_t*)(ws + W_OUTE), 1, 32, scr, r, lane); continue; } r -= I1;
            if (r < I2) { tr_item(P.in[13], 1024, 3072, P.in[1] + 1024, (bf16_t*)(ws + W_QKV), 2, 96, scr, r, lane); continue; } r -= I2;
            if (r < I3) { tr_item(P.in[14], 1024, 1024, nullptr, (bf16_t*)(ws + W_OUTO), 1, 32, scr, r, lane); continue; } r -= I3;
            if (r < I4) { tr_item(P.in[15], 1024, 5632, P.in[2], (bf16_t*)(ws + W_GU0), 3, 176, scr, r, lane); continue; } r -= I4;
            if (r < I4) { tr_item(P.in[15] + (size_t)1024 * 5632, 1024, 5632, P.in[2] + 1024, (bf16_t*)(ws + W_GU1), 3, 176, scr, r, lane); continue; } r -= I4;
            if (r < I6) { tr_item(P.in[16], 2816, 1024, nullptr, (bf16_t*)(ws + W_DN0), 1, 32, scr, r, lane); continue; } r -= I6;
            if (r < I6) { tr_item(P.in[16] + (size_t)2816 * 1024, 2816, 1024, nullptr, (bf16_t*)(ws + W_DN1), 1, 32, scr, r, lane); continue; } r -= I6;
            if (r < I8) { tr_item(P.in[8], 2048, 256, nullptr, (bf16_t*)(ws + W_W1), 1, 8, scr, r, lane); continue; } r -= I8;
            if (r < I8) { tr_item(P.in[10], 2048, 256, nullptr, (bf16_t*)(ws + W_W1) + (size_t)256 * 2048, 1, 8, scr, r, lane); continue; } r -= I8;
            if (r < I10) { tr_item(P.in[9], 256, 64, nullptr, (bf16_t*)(ws + W_W2), 4, 8, scr, r, lane); continue; } r -= I10;
            tr_item(P.in[11], 256, 64, nullptr, (bf16_t*)(ws + W_W2) + (size_t)256 * 256, 5, 8, scr, r, lane);
        }
        for (int e = bx * 512 + tid; e < T * 32; e += G * 512) { const int t = e >> 5, i = e & 31; float c, s; sincos_d((float)t * P.inv_freq[i], c, s); cosT[e] = c; sinT[e] = s; }
        if (bx >= G - 32) {
            const int c = G - 1 - bx, j = tid; const float* pe = j < 256 ? P.in[6] : P.in[7]; const float* w1 = j < 256 ? P.in[8] : P.in[10];
            float s = 0.f;
#pragma unroll 16
            for (int kk = c * 64; kk < c * 64 + 64; ++kk) s += *(const GAS float*)(pe + kk) * *(const GAS float*)(w1 + (size_t)kk * 256 + (j & 255));
            *(GAS float*)(bias1 + 512 + c * 512 + j) = s;
        }
        for (int mrow = gw; mrow < M; mrow += NGW) row_to_bf16_ss(P.in[0] + (size_t)mrow * D, XB + (size_t)mrow * D, SS + (size_t)mrow * 16, lane);
    }
    grid.sync();
    const XcdBarrier xbar = xcd_barrier_post(barw, barst, wave0);
#define GRID_BAR() do { XcdBarrier t_ = xbar; asm volatile("" : "+s"(t_.x), "+s"(t_.bar)); xcd_barrier(t_); } while (0)
    {   WS_SETUP();
        if (bx == 0) { TID_SETUP(); float s = 0.f;
#pragma unroll 8
            for (int c = 0; c < 32; ++c) s += *(const GAS float*)(bias1 + 512 + c * 512 + tid);
            *(GAS float*)(bias1 + tid) = s; }
        pg8::Gemm g{XB, (const bf16_t*)(ws + W_IN), M, 2304, 1024, 1024, 128, 0, (long)256 * 1024 * 2, 0, 0};
        pg8::StaticOrder S; S.init(M, 2304, G, bx);
        const unsigned rope = 0xFu | (1u << 6) | (1u << 8) | (0xFu << 10) | (1u << 14), dual = 0xFu, scal = 0xFu | (0xFu << 10);
        EpiZ<0> E{Z, ZP0, rope, dual, scal, C_AQR, cosT, sinT, SS};
        pg8::gemm_phase<EpiZ<0>, pg8::StaticOrder, true, true>(lds, g, S, E, wave0);
    }
    GRID_BAR();
    {   WS_SETUP();
        pg8::Gemm g{Z, (const bf16_t*)(ws + W_W1), 32 * 256, 512, 2048, 16 * ZP0, ZP0 * 2, 1, (long)T * ZP0 * 2, 64 * 2, 128 * 2};
        g.A = Z + C_AKC;
        pg8::StaticOrder S; S.init(32 * 256, 512, G, bx);
        EpiB<1> E{HID, 512, bias1};
        pg8::gemm_phase<EpiB<1>, pg8::StaticOrder, true, true>(lds, g, S, E, wave0);
        asm volatile("s_waitcnt vmcnt(0)" ::: "memory");
        __builtin_amdgcn_fence(__ATOMIC_RELEASE, "agent"); __syncthreads(); __builtin_amdgcn_fence(__ATOMIC_ACQUIRE, "agent");
        {
            pg8::Gemm g2{HID, (const bf16_t*)(ws + W_W2), 32 * 256, 512, 256, 512, 128, 0, (long)256 * 512 * 2, 0, 256 * 2};
            EpiB<0> E2{KVC, 512, nullptr};
            pg8::gemm_phase<EpiB<0>, pg8::StaticOrder, true, true>(lds, g2, S, E2, wave0);
        }
        __syncthreads();
        if (G > 64) {
            if (bx < 64) { for (int j = 0; j < 4; ++j) { const int u = bx * 4 + j, qb = u & 63, bh = u >> 6; b_unit(Z, MIX, P.in[12], lds, bh >> 1, bh & 1, qb, gt, wave0); } }
            else { for (int u = 256 + (bx - 64); u < 2048; u += G - 64) { const int qb = u & 63, bh = u >> 6; b_unit(Z, MIX, P.in[12], lds, bh >> 1, bh & 1, qb, gt, wave0); } }
        } else { for (int u = bx; u < 2048; u += G) { const int qb = u & 63, bh = u >> 6; b_unit(Z, MIX, P.in[12], lds, bh >> 1, bh & 1, qb, gt, wave0); } }
        __syncthreads();
    }
    GRID_BAR();
    {   WS_SETUP();
        for (int i = 0; i * G + bx < 2048; ++i) { const int u = i * G + bx, j = u >> 5, lvl = j & 7, rnd = j >> 3; const int qb = 63 - (8 * rnd + ((rnd & 1) ? 7 - lvl : lvl)); const int bh = u & 31;
            nsa_unit(Z, KVC, MIX, lds, bh >> 1, bh & 1, qb, gt, wave0); }
        __syncthreads();
    }
    GRID_BAR();
    {   WS_SETUP();
        pg8::Gemm g{MIX, (const bf16_t*)(ws + W_OUTE), M, 1024, 1024, 1024, 128, 0, (long)256 * 1024 * 2, 0, 0};
        pg8::StaticOrder S; S.init(M, 1024, G, bx);
        EpiRes<false> E{nullptr, XB, SS, 1024};
        pg8::gemm_phase<EpiRes<false>, pg8::StaticOrder, true, true>(lds, g, S, E, wave0);
    }
    GRID_BAR();
    for (int layer = 0; layer < 2; ++layer) {
        if (layer == 1) {
            {   WS_SETUP();
                pg8::Gemm g{XB, (const bf16_t*)(ws + W_QKV), M, 3072, 1024, 1024, 128, 0, (long)256 * 1024 * 2, 0, 0};
                pg8::StaticOrder S; S.init(M, 3072, G, bx);
                EpiZ<1> E{Z, ZP1, 0xFFFFu, 0u, 0xFFu, 0, cosT, sinT, SS};
                pg8::gemm_phase<EpiZ<1>, pg8::StaticOrder, true, true>(lds, g, S, E, wave0);
            }
            GRID_BAR();
            for (int pi = 0; pi < 3; ++pi) {
                WS_SETUP();
                c_phase(Z, MIX, LSE, lds, pi, bx, G, gt, wave0, 4096);
                __syncthreads();
                GRID_BAR();
            }
            {   WS_SETUP();
                pg8::Gemm g{MIX, (const bf16_t*)(ws + W_OUTO), M, 1024, 1024, 1024, 128, 0, (long)256 * 1024 * 2, 0, 0};
                pg8::StaticOrder S; S.init(M, 1024, G, bx);
                EpiRes<false> E{nullptr, XB, SS, 1024};
                pg8::gemm_phase<EpiRes<false>, pg8::StaticOrder, true, true>(lds, g, S, E, wave0);
            }
            GRID_BAR();
        }
        {   WS_SETUP();
            pg8::Gemm g{XB, (const bf16_t*)(ws + (layer == 0 ? W_GU0 : W_GU1)), M, 5632, 1024, 1024, 128, 0, (long)256 * 1024 * 2, 0, 0};
            pg8::StaticOrder S; S.init(M, 5632, G, bx);
            EpiSwiglu E{H, FF, SS};
            pg8::gemm_phase<EpiSwiglu, pg8::StaticOrder, true, true>(lds, g, S, E, wave0);
        }
        GRID_BAR();
        {   WS_SETUP();
            pg8::Gemm g{H, (const bf16_t*)(ws + (layer == 0 ? W_DN0 : W_DN1)), M, 1024, FF, FF, 128, 0, (long)256 * FF * 2, 0, 0};
            pg8::StaticOrder S; S.init(M, 1024, G, bx, 1);
            EpiRes<false> E{nullptr, XB, SS, 1024};
            pg8::gemm_phase<EpiRes<false>, pg8::StaticOrder, true, true>(lds, g, S, E, wave0);
        }
        GRID_BAR();
    }
    { TID_SETUP(); WS_SETUP();
    for (int mrow = gw; mrow < M; mrow += NGW) rms_row_final(XB + (size_t)mrow * D, X + (size_t)mrow * D, P.in[3], SS + (size_t)mrow * 16, lane); }
}

extern "C" void kernel_launch(void* const* d_in, const int* in_sizes, int n_in, void* d_out, int out_size, void* d_ws, size_t ws_size, hipStream_t stream) {
    static int grid = 0;
    if (grid == 0) {
        if (n_in != 17 || out_size != M * D || ws_size < WS_END) { fprintf(stderr, "kernel_launch: unexpected problem shape (n_in %d out %d ws %zu)\n", n_in, out_size, ws_size); grid = -1; return; }
        int dev = 0, cus = 0, per_cu = 0;
        hipGetDevice(&dev); hipDeviceGetAttribute(&cus, hipDeviceAttributeMultiprocessorCount, dev);
        hipFuncSetAttribute((const void*)fwd_mega, hipFuncAttributeMaxDynamicSharedMemorySize, LDS_BYTES);
        hipOccupancyMaxActiveBlocksPerMultiprocessor(&per_cu, (const void*)fwd_mega, 512, LDS_BYTES);
        if (per_cu < 1) { fprintf(stderr, "kernel_launch: occupancy query says %d blocks per CU\n", per_cu); per_cu = 1; }
        (void)hipGetLastError();
        grid = cus * 1;
    }
    if (grid < 0) return;
    Params p{};
    for (int i = 0; i < 17; ++i) p.in[i] = (const float*)d_in[i];
    p.out = (float*)d_out; p.ws = (unsigned char*)d_ws;
    for (int i = 0; i < 32; ++i) p.inv_freq[i] = 1.0f / powf(10000.0f, (float)(2 * i) / 64.0f);
    void* args[] = {&p};
    hipError_t e = hipLaunchCooperativeKernel((const void*)fwd_mega, dim3(grid), dim3(512), args, LDS_BYTES, stream);
    if (e != hipSuccess) fprintf(stderr, "cooperative launch failed: %s (grid %d)\n", hipGetErrorString(e), grid);
}
```

```cpp
#include <hip/hip_runtime.h>
#include <hip/hip_cooperative_groups.h>
#include <hip/hip_bf16.h>
#include <cstdio>
#include <cstdint>
namespace cg = cooperative_groups;
namespace pg8 {
#define PG8_LAS __attribute__((address_space(3)))
typedef unsigned short bf16_t;
typedef short bf16x8 __attribute__((ext_vector_type(8)));
typedef float f32x4 __attribute__((ext_vector_type(4)));
typedef unsigned u32x4 __attribute__((ext_vector_type(4)));
struct Unit { int pm, pn; };
constexpr int BM = 256, BK = 64, HALF = 128, HTB = HALF * BK * 2  , STAGE_BYTES = 8 * HTB, NXCD = 8, WGM = 4;

__host__ __device__ __forceinline__ int lds_byte(int r, int c) { const int st = (r >> 4) * 2 + (c >> 5), rr = r & 15, cc = c & 31, ob = rr * 64 + cc * 2; return st * 1024 + (ob ^ (((ob >> 9) & 1) << 5)); }
__host__ __device__ __forceinline__ void stage_rc(int b, int& R, int& C) { const int st = b / 1024, sb = b % 1024, swz = sb ^ (((sb >> 9) & 1) << 5); R = (st >> 1) * 16 + swz / 64; C = (st & 1) * 32 + (swz % 64) / 2; }
__host__ __device__ __forceinline__ int perm32(int rho) { const int n = rho >> 4, i = rho & 15; return 8 * (i >> 2) + 4 * n + (i & 3); }

struct Gemm { const bf16_t* A; const bf16_t* Bt; int M, N, K; int lda; int kstepA; int sh; long s1, s0, sp; };
__device__ __forceinline__ const char* a_base(const Gemm& g, const struct Unit& u);

struct StaticOrder {
    int nM, nN, nwg, G, c, rev;
    __host__ __device__ void init(int M, int N, int G_, int c_, int rev_ = 0) { nM = M / BM; nN = N / BM; nwg = nM * nN; G = G_; c = c_; rev = rev_; }
    __host__ __device__ bool next(int i, Unit& u) const {
        const long L = (long)i * G + c; if (L >= nwg) return false;
        int wgid = (int)L; { const int q = nwg / NXCD, r = nwg % NXCD, xcd = wgid % NXCD, off = wgid / NXCD; wgid = (xcd < r ? xcd * (q + 1) : r * (q + 1) + (xcd - r) * q) + off; }
        const int nig = WGM * nN, gid = wgid / nig, fm = gid * WGM, gsz = (nM - fm) < WGM ? (nM - fm) : WGM;
        u.pm = fm + ((wgid % nig) % gsz); u.pn = (wgid % nig) / gsz; if (rev) u.pm = nM - 1 - u.pm; return true;
    }
    __device__ __forceinline__ void a_ready(const Unit&) const {}
    __device__ __forceinline__ void done(const Unit&) const {}
};


__device__ __forceinline__ const char* a_base(const Gemm& g, const Unit& u) { return (const char*)g.A + (size_t)(u.pm >> g.sh) * g.s1 + (size_t)(u.pm & ((1 << g.sh) - 1)) * g.s0 + (size_t)u.pn * g.sp; }
template <class Epi, class Sched, bool ALIGN_EPI = false, bool SP2 = false>
__device__ __forceinline__ void gemm_phase(PG8_LAS unsigned char* lds, const Gemm g, const Sched& S, const Epi& E, int wave0) {
    int tid_; asm volatile("v_mbcnt_lo_u32_b32 %0, -1, 0\n\tv_mbcnt_hi_u32_b32 %0, -1, %0" : "=&v"(tid_)); tid_ += wave0 * 64; const int tid = tid_, wid = __builtin_amdgcn_readfirstlane(tid >> 6), lane = tid & 63, wr = wid >> 2, wc = wid & 3, fr = lane & 15, fq = lane >> 4;
    const int K = g.K, nt = K / BK;
    unsigned voffA[2], voffB[2];
#pragma unroll
    for (int i = 0; i < 2; ++i) { int R, C; stage_rc(tid * 16 + i * 8192, R, C); const int Rb = Epi::PERM ? ((R & ~31) + perm32(R & 31)) : R;
        voffA[i] = (unsigned)(R * g.lda + C) * 2u; voffB[i] = (unsigned)(Rb * K + C) * 2u; }
    const size_t kstep = (size_t)(BK * 2); const size_t kstepA = (size_t)g.kstepA; const size_t hstepA = (size_t)HALF * g.lda * 2;
    const size_t hstep = (size_t)HALF * K * 2;
    const size_t tstep = 2 * hstep;
    const unsigned ldsw = (unsigned)wid * 1024u;
    const int aoff = lds_byte(wr * 64 + fr, fq * 8), boff = lds_byte(wc * 32 + fr, fq * 8);
#define PG8_SA(b, h) (((b) * 2 + (h)) * HTB)
#define PG8_SB(b, h) ((4 + (b) * 2 + (h)) * HTB)
#define PG8_STAGE(bufoff, gbase, voff) do { _Pragma("unroll") for (int _i = 0; _i < 2; ++_i) \
        __builtin_amdgcn_global_load_lds((const unsigned*)((const char*)(gbase) + (voff)[_i]), (PG8_LAS unsigned*)(lds + (bufoff) + ldsw + _i * 8192), 16, 0, 0); } while (0)
#define PG8_LDA(dst, b, h) do { _Pragma("unroll") for (int m = 0; m < 4; ++m) _Pragma("unroll") for (int k = 0; k < 2; ++k) dst[m][k] = *(const PG8_LAS bf16x8*)(lds + PG8_SA(b, h) + aoff + m * 2048 + k * 1024); } while (0)
#define PG8_LDB(dst, b, h) do { _Pragma("unroll") for (int n = 0; n < 2; ++n) _Pragma("unroll") for (int k = 0; k < 2; ++k) dst[n][k] = *(const PG8_LAS bf16x8*)(lds + PG8_SB(b, h) + boff + n * 2048 + k * 1024); } while (0)
#define PG8_MMA(ai, bj, At, Bt) do { __builtin_amdgcn_s_setprio(1); _Pragma("unroll") for (int m = 0; m < 4; ++m) _Pragma("unroll") for (int n = 0; n < 2; ++n) _Pragma("unroll") for (int k = 0; k < 2; ++k) \
        acc[ai][bj][m][n] = __builtin_amdgcn_mfma_f32_16x16x32_bf16(Bt[n][k], At[m][k], acc[ai][bj][m][n], 0, 0, 0); __builtin_amdgcn_s_setprio(0); } while (0)
#define PG8_WAIT_V(n) asm volatile("s_waitcnt vmcnt(" #n ")" ::: "memory")
#define PG8_WAIT_L(n) asm volatile("s_waitcnt lgkmcnt(" #n ")" ::: "memory")
#define PG8_BAR __builtin_amdgcn_s_barrier()
#define PG8_SCHED __builtin_amdgcn_sched_barrier(0)
    Unit cur, nxt; int ui = 0;
    if (!S.next(0, cur)) return;
    f32x4 acc[2][2][4][2];
#pragma unroll
    for (int a = 0; a < 2; ++a)
#pragma unroll
        for (int b = 0; b < 2; ++b)
#pragma unroll
            for (int m = 0; m < 4; ++m)
#pragma unroll
                for (int n = 0; n < 2; ++n) acc[a][b][m][n] = (f32x4){0.f, 0.f, 0.f, 0.f};
    bf16x8 At[4][2], B0[2][2], B1[2][2];
    const char* cA = a_base(g, cur); const char* cB = (const char*)g.Bt + (size_t)cur.pn * tstep;
    S.a_ready(cur);
    if constexpr (SP2) {
        PG8_STAGE(PG8_SB(0, 0), cB, voffB); PG8_STAGE(PG8_SB(0, 1), cB + hstep, voffB); PG8_STAGE(PG8_SA(0, 0), cA, voffA); PG8_STAGE(PG8_SA(0, 1), cA + hstepA, voffA);
        if (wr == 1) PG8_BAR;
        PG8_WAIT_V(2); PG8_BAR;
        PG8_STAGE(PG8_SB(1, 0), cB + kstep, voffB); PG8_STAGE(PG8_SA(1, 0), cA + kstepA, voffA); PG8_STAGE(PG8_SB(1, 1), cB + hstep + kstep, voffB);
        PG8_WAIT_V(6); PG8_BAR;
    } else {
        PG8_STAGE(PG8_SB(0, 0), cB, voffB); PG8_STAGE(PG8_SA(0, 0), cA, voffA); PG8_STAGE(PG8_SB(0, 1), cB + hstep, voffB); PG8_STAGE(PG8_SA(0, 1), cA + hstepA, voffA);
        if (wr == 1) PG8_BAR;
        PG8_WAIT_V(4); PG8_BAR;
        PG8_STAGE(PG8_SB(1, 0), cB + kstep, voffB); PG8_STAGE(PG8_SA(1, 0), cA + kstepA, voffA); PG8_STAGE(PG8_SB(1, 1), cB + hstep + kstep, voffB);
        PG8_WAIT_V(6); PG8_BAR;
    }
    for (;;) {
        const bool has_next = S.next(ui + 1, nxt);
        const char* nA = has_next ? a_base(g, nxt) : cA; const char* nB = has_next ? (const char*)g.Bt + (size_t)nxt.pn * tstep : cB;
        for (int t = 0; t < nt; t += 2) {
            const bool last = (t == nt - 2);
            const char* a1 = cA + (size_t)(t + 1) * kstepA;
            const char* a2 = last ? nA : cA + (size_t)(t + 2) * kstepA; const char* b2 = last ? nB : cB + (size_t)(t + 2) * kstep;
            const char* a3 = a2 + kstepA; const char* b3 = b2 + kstep;
            if (last && has_next) S.a_ready(nxt);
            if constexpr (SP2) {
            PG8_LDB(B0, 0, 0); PG8_LDB(B1, 0, 1); PG8_SCHED; PG8_LDA(At, 0, 0); PG8_STAGE(PG8_SA(1, 1), a1 + hstepA, voffA);
            PG8_WAIT_V(8); PG8_WAIT_L(0); PG8_BAR; PG8_MMA(0, 0, At, B0); PG8_MMA(0, 1, At, B1); PG8_BAR; PG8_SCHED;
            PG8_LDA(At, 0, 1); PG8_STAGE(PG8_SB(0, 0), b2, voffB); PG8_STAGE(PG8_SB(0, 1), b2 + hstep, voffB); PG8_STAGE(PG8_SA(0, 0), a2, voffA);
            PG8_WAIT_V(8); PG8_WAIT_L(0); PG8_BAR; PG8_MMA(1, 0, At, B0); PG8_MMA(1, 1, At, B1); PG8_BAR; PG8_SCHED;
            PG8_LDB(B0, 1, 0); PG8_LDB(B1, 1, 1); PG8_SCHED; PG8_LDA(At, 1, 0); PG8_STAGE(PG8_SA(0, 1), a2 + hstepA, voffA);
            PG8_WAIT_V(8); PG8_WAIT_L(0); PG8_BAR; PG8_MMA(0, 0, At, B0); PG8_MMA(0, 1, At, B1); PG8_BAR; PG8_SCHED;
            PG8_LDA(At, 1, 1); PG8_STAGE(PG8_SB(1, 0), b3, voffB); PG8_STAGE(PG8_SB(1, 1), b3 + hstep, voffB); PG8_STAGE(PG8_SA(1, 0), a3, voffA);
            PG8_WAIT_V(8); PG8_WAIT_L(0); PG8_BAR; PG8_MMA(1, 0, At, B0); PG8_MMA(1, 1, At, B1); PG8_BAR; PG8_SCHED;
            } else {
            PG8_LDB(B0, 0, 0); PG8_SCHED; PG8_LDA(At, 0, 0); PG8_STAGE(PG8_SA(1, 1), a1 + hstepA, voffA);
            PG8_WAIT_L(8); PG8_BAR; PG8_WAIT_L(0); PG8_MMA(0, 0, At, B0); PG8_BAR; PG8_SCHED;
            PG8_LDB(B1, 0, 1); PG8_STAGE(PG8_SB(0, 0), b2, voffB);
            PG8_BAR; PG8_WAIT_L(0); PG8_MMA(0, 1, At, B1); PG8_BAR;
            PG8_LDA(At, 0, 1); PG8_STAGE(PG8_SA(0, 0), a2, voffA);
            PG8_BAR; PG8_WAIT_L(0); PG8_MMA(1, 0, At, B0); PG8_BAR; PG8_SCHED;
            PG8_STAGE(PG8_SB(0, 1), b2 + hstep, voffB);
            PG8_WAIT_V(6); PG8_BAR; PG8_MMA(1, 1, At, B1); PG8_BAR;
            PG8_LDB(B0, 1, 0); PG8_SCHED; PG8_LDA(At, 1, 0); PG8_STAGE(PG8_SA(0, 1), a2 + hstepA, voffA);
            PG8_WAIT_L(8); PG8_BAR; PG8_WAIT_L(0); PG8_MMA(0, 0, At, B0); PG8_BAR; PG8_SCHED;
            PG8_LDB(B1, 1, 1); PG8_STAGE(PG8_SB(1, 0), b3, voffB);
            PG8_BAR; PG8_WAIT_L(0); PG8_MMA(0, 1, At, B1); PG8_BAR;
            PG8_LDA(At, 1, 1); PG8_STAGE(PG8_SA(1, 0), a3, voffA);
            PG8_BAR; PG8_WAIT_L(0); PG8_MMA(1, 0, At, B0); PG8_BAR; PG8_SCHED;
            PG8_STAGE(PG8_SB(1, 1), b3 + hstep, voffB);
            PG8_WAIT_V(6); PG8_BAR; PG8_MMA(1, 1, At, B1); PG8_BAR;
            }
        }
        if constexpr (ALIGN_EPI) { if (wr == 0) PG8_BAR; }
        if constexpr (!Epi::AFTER_DRAIN) { E(acc, cur, wr, wc, fr, fq); S.done(cur); }
        if (!has_next) break;
#pragma unroll
        for (int a = 0; a < 2; ++a)
#pragma unroll
            for (int b = 0; b < 2; ++b)
#pragma unroll
                for (int m = 0; m < 4; ++m)
#pragma unroll
                    for (int n = 0; n < 2; ++n) acc[a][b][m][n] = (f32x4){0.f, 0.f, 0.f, 0.f};
        cur = nxt; cA = nA; cB = nB; ++ui;
        if constexpr (ALIGN_EPI) { if (wr == 1) PG8_BAR; }
    }
    PG8_WAIT_V(0);
    if constexpr (!ALIGN_EPI) { if (wr == 0) PG8_BAR; }
    PG8_BAR;
    if constexpr (Epi::AFTER_DRAIN) { E.fused(acc, cur, wr, wc, fr, fq, lds, wid, lane); S.done(cur); }
#undef PG8_SA
#undef PG8_SB
#undef PG8_STAGE
#undef PG8_LDA
#undef PG8_LDB
#undef PG8_MMA
#undef PG8_WAIT_V
#undef PG8_WAIT_L
#undef PG8_BAR
#undef PG8_SCHED
}
}

using pg8::bf16_t; using pg8::bf16x8; using pg8::f32x4; using pg8::u32x4; using pg8::Unit;
#define LAS __attribute__((address_space(3)))
#define GAS_ __attribute__((address_space(1)))
typedef LAS unsigned char* ldsp;
typedef float f32x16 __attribute__((ext_vector_type(16)));
typedef short s16x4 __attribute__((ext_vector_type(4)));
typedef float f32x2_t __attribute__((ext_vector_type(2)));
typedef __bf16 bf16x2_t __attribute__((ext_vector_type(2)));
typedef unsigned u32x2 __attribute__((ext_vector_type(2)));

constexpr int NB = 16, T = 4096, D = 1024, M = NB * T, FF = 2816;
constexpr int ZP0 = 2816, ZP1 = 3072;
constexpr int C_AQP = 0, C_AKC = 512, C_AVC = 640, C_AKS = 768, C_AVS = 896, C_AKW = 1024, C_AVW = 1152, C_BQ = 1280, C_BK = 1792, C_BV = 1920, C_GATE = 2048, C_AQR = 2304;
constexpr float LOG2E = 1.4426950408889634f;
constexpr float C2 = 0.125f * LOG2E;
constexpr float NORM_EPS = 1e-5f;
constexpr float NEG_INF = -__builtin_huge_valf();

constexpr size_t MiB = 1u << 20;
constexpr size_t WS_BAR = 1536 * 1024;
constexpr size_t WS_COS = 0, WS_SIN = 512 * 1024, WS_BIAS1 = 1 * MiB, WS_LSE = 2 * MiB, WS_HID = 6 * MiB, WS_KVC = 14 * MiB;
constexpr size_t W_IN = 22 * MiB, W_OUTE = W_IN + 2304ull * 1024 * 2, W_QKV = W_OUTE + 2 * MiB, W_OUTO = W_QKV + 6 * MiB, W_GU0 = W_OUTO + 2 * MiB, W_GU1 = W_GU0 + 11 * MiB,
                 W_DN0 = W_GU1 + 11 * MiB, W_DN1 = W_DN0 + 5632ull * 1024, W_W1 = W_DN1 + 5632ull * 1024, W_W2 = W_W1 + 2 * MiB, W_END = W_W2 + 256 * 1024;
static_assert(W_END <= 72 * MiB, "weights");
constexpr size_t WS_XN = 72 * MiB;
constexpr size_t WS_Z = 200 * MiB;
constexpr size_t WS_XB = 592 * MiB;
constexpr size_t WS_SS = 720 * MiB;
constexpr size_t WS_END = 724 * MiB;

constexpr int LDS_BYTES = 147456;
constexpr int LDS_WSF = 143360;
constexpr int LDS_BARST = 145472;
constexpr int LDS_NSA_RING = 65536, LDS_NSA_IMP = 98304, NSA_IMP_STRIDE = 4352;

struct Params { const float* in[17]; float* out; unsigned char* ws; float inv_freq[32]; };

#define LDS_WAIT() asm volatile("s_waitcnt lgkmcnt(0)" ::: "memory")
__device__ __forceinline__ unsigned f2bf(float f) { unsigned u = __builtin_bit_cast(unsigned, f); return (u + 0x7fffu + ((u >> 16) & 1u)) >> 16; }
__device__ __forceinline__ unsigned pk2(float lo, float hi) { f32x2_t v = {lo, hi}; bf16x2_t b = __builtin_convertvector(v, bf16x2_t); return __builtin_bit_cast(unsigned, b); }
__device__ __forceinline__ float bf2f(bf16_t v) { return __builtin_bit_cast(float, (unsigned)v << 16); }
__device__ __forceinline__ float wave_sum(float v) {
#pragma unroll
    for (int o = 1; o < 64; o <<= 1) v += __shfl_xor(v, o);
    return v;
}
__device__ __forceinline__ float fexp2(float x) { return __builtin_amdgcn_exp2f(x); }
__device__ __forceinline__ float silu_f(float g) { return g * __builtin_amdgcn_rcpf(1.0f + __expf(-g)); }
__device__ __forceinline__ float sigmoid_f(float g) { return __builtin_amdgcn_rcpf(1.0f + __expf(-g)); }


__device__ __forceinline__ void rows_rstd(float (&rs)[2][4], const float* SS, int row0, int fq) {
    f32x4 q[2][4];
#pragma unroll
    for (int ai = 0; ai < 2; ++ai)
#pragma unroll
        for (int m = 0; m < 4; ++m) q[ai][m] = *(const GAS_ f32x4*)(SS + (size_t)(row0 + ai * 128 + m * 16) * 16 + fq * 4);
#pragma unroll
    for (int ai = 0; ai < 2; ++ai)
#pragma unroll
        for (int m = 0; m < 4; ++m) { float s = (q[ai][m][0] + q[ai][m][1]) + (q[ai][m][2] + q[ai][m][3]); s += __shfl_xor(s, 16); s += __shfl_xor(s, 32);
            rs[ai][m] = 1.0f / sqrtf(s * (1.0f / 1024.0f) + 1e-5f); }
}
template <int HM> struct EpiZ {
    static constexpr bool PERM = true, AFTER_DRAIN = false;
    bf16_t* Z; int ldz; unsigned ropeMask, dualMask, scaleMask; int dualOff; const float* cosT; const float* sinT; const float* SS;
    __device__ __forceinline__ void operator()(const f32x4 (&acc)[2][2][4][2], const Unit& u, int wr, int wc, int fr, int fq) const {
        const int row0 = u.pm * 256 + wr * 64 + fr, col0 = u.pn * 256 + wc * 32 + 8 * fq, j0 = 16 * (wc & 1) + 4 * fq;
        float rsv[2][4];
        if (SS) rows_rstd(rsv, SS, row0, fq);
        const bool anyrope = ((ropeMask >> (2 * u.pn)) & 3u) != 0u;
#pragma unroll
        for (int ai = 0; ai < 2; ++ai) {
            f32x4 cc[4], ss[4];
            if (anyrope) {
#pragma unroll
                for (int m = 0; m < 4; ++m) { const int t = (row0 + ai * 128 + m * 16) & (T - 1); cc[m] = *(const GAS_ f32x4*)(cosT + t * 32 + j0); ss[m] = *(const GAS_ f32x4*)(sinT + t * 32 + j0); }
            }
            asm volatile("" ::: "memory");
#pragma unroll
            for (int m = 0; m < 4; ++m) {
                const int row = row0 + ai * 128 + m * 16;
                const f32x4 c4 = cc[m], s4 = ss[m];
                bf16_t* rowp = HM ? Z + ((size_t)(((row >> 12) * 3 + (col0 >> 10)) * 16 + ((col0 & 1023) >> 6)) * T + (row & (T - 1))) * 64 + (col0 & 63) : Z + (size_t)row * ldz + col0;
                constexpr int bjstep = HM ? 2 * T * 64 : 128;
                const float rs = SS ? rsv[ai][m] : 1.0f;
#pragma unroll
                for (int bj = 0; bj < 2; ++bj) {
                    const int h = u.pn * 2 + bj;
                    if (HM == 0 && col0 + bj * 128 >= 2072) continue;
                    const float sc = ((scaleMask >> h) & 1u) ? rs * C2 : rs;
                    f32x4 v0 = acc[ai][bj][m][0] * sc, v1 = acc[ai][bj][m][1] * sc;
                    int off = bj * bjstep;
                    if ((dualMask >> h) & 1u) { u32x4 w; w.x = pk2(v0[0], v0[1]); w.y = pk2(v0[2], v0[3]); w.z = pk2(v1[0], v1[1]); w.w = pk2(v1[2], v1[3]); *(GAS_ u32x4*)(rowp + off) = w; off += dualOff; }
                    if ((ropeMask >> h) & 1u) {
                        f32x4 a, b2;
                        a[0] = v0[0] * c4[0] - v0[1] * s4[0]; a[1] = v0[1] * c4[0] + v0[0] * s4[0];
                        a[2] = v0[2] * c4[1] - v0[3] * s4[1]; a[3] = v0[3] * c4[1] + v0[2] * s4[1];
                        b2[0] = v1[0] * c4[2] - v1[1] * s4[2]; b2[1] = v1[1] * c4[2] + v1[0] * s4[2];
                        b2[2] = v1[2] * c4[3] - v1[3] * s4[3]; b2[3] = v1[3] * c4[3] + v1[2] * s4[3];
                        v0 = a; v1 = b2;
                    }
                    u32x4 w; w.x = pk2(v0[0], v0[1]); w.y = pk2(v0[2], v0[3]); w.z = pk2(v1[0], v1[1]); w.w = pk2(v1[2], v1[3]);
                    *(GAS_ u32x4*)(rowp + off) = w;
                }
                asm volatile("" ::: "memory");
            }
        }
    }
};
struct EpiSwiglu {
    static constexpr bool PERM = true, AFTER_DRAIN = false;
    bf16_t* H; int ldh; const float* SS;
    __device__ __forceinline__ void operator()(const f32x4 (&acc)[2][2][4][2], const Unit& u, int wr, int wc, int fr, int fq) const {
        const int row0 = u.pm * 256 + wr * 64 + fr, hc0 = u.pn * 128 + wc * 32 + 8 * fq;
        float rsv[2][4];
        rows_rstd(rsv, SS, row0, fq);
#pragma unroll
        for (int ai = 0; ai < 2; ++ai)
#pragma unroll
            for (int m = 0; m < 4; ++m) {
                bf16_t* rowp = H + (size_t)(row0 + ai * 128 + m * 16) * ldh + hc0;
                const float rs = rsv[ai][m];
                const f32x4 g0 = acc[ai][0][m][0] * rs, g1 = acc[ai][0][m][1] * rs, u0 = acc[ai][1][m][0] * rs, u1 = acc[ai][1][m][1] * rs;
                u32x4 w; w.x = pk2(silu_f(g0[0]) * u0[0], silu_f(g0[1]) * u0[1]); w.y = pk2(silu_f(g0[2]) * u0[2], silu_f(g0[3]) * u0[3]);
                w.z = pk2(silu_f(g1[0]) * u1[0], silu_f(g1[1]) * u1[1]); w.w = pk2(silu_f(g1[2]) * u1[2], silu_f(g1[3]) * u1[3]);
                *(GAS_ u32x4*)rowp = w;
                asm volatile("" ::: "memory");
            }
    }
};
template <bool BASE_F32> struct EpiRes {
    static constexpr bool PERM = true, AFTER_DRAIN = false;
    const float* basef; bf16_t* XB; float* SS; int ldc;
    __device__ __forceinline__ void operator()(const f32x4 (&acc)[2][2][4][2], const Unit& u, int wr, int wc, int fr, int fq) const {
        const int row0 = u.pm * 256 + wr * 64 + fr, col0 = u.pn * 256 + wc * 32 + 8 * fq;
#pragma unroll
        for (int ai = 0; ai < 2; ++ai) {
            f32x4 bs[4][2][2]; u32x4 bh[4][2];
#pragma unroll
            for (int m = 0; m < 4; ++m) { const size_t off = (size_t)(row0 + ai * 128 + m * 16) * ldc + col0;
#pragma unroll
                for (int bj = 0; bj < 2; ++bj) {
                    if (BASE_F32) { bs[m][bj][0] = *(const GAS_ f32x4*)(basef + off + bj * 128); bs[m][bj][1] = *(const GAS_ f32x4*)(basef + off + bj * 128 + 4); }
                    else bh[m][bj] = *(const GAS_ u32x4*)(XB + off + bj * 128); } }
            asm volatile("" ::: "memory");
#pragma unroll
            for (int m = 0; m < 4; ++m) {
                const size_t off = (size_t)(row0 + ai * 128 + m * 16) * ldc + col0;
                float ssq = 0.f;
#pragma unroll
                for (int bj = 0; bj < 2; ++bj) {
                    f32x4 b0, b1;
                    if (BASE_F32) { b0 = bs[m][bj][0]; b1 = bs[m][bj][1]; }
                    else { const u32x4 h = bh[m][bj];
                        b0 = (f32x4){__builtin_bit_cast(float, h.x << 16), __builtin_bit_cast(float, h.x & 0xffff0000u), __builtin_bit_cast(float, h.y << 16), __builtin_bit_cast(float, h.y & 0xffff0000u)};
                        b1 = (f32x4){__builtin_bit_cast(float, h.z << 16), __builtin_bit_cast(float, h.z & 0xffff0000u), __builtin_bit_cast(float, h.w << 16), __builtin_bit_cast(float, h.w & 0xffff0000u)}; }
                    const f32x4 v0 = b0 + acc[ai][bj][m][0], v1 = b1 + acc[ai][bj][m][1];
                    ssq += ((v0[0] * v0[0] + v0[1] * v0[1]) + (v0[2] * v0[2] + v0[3] * v0[3])) + ((v1[0] * v1[0] + v1[1] * v1[1]) + (v1[2] * v1[2] + v1[3] * v1[3]));
                    u32x4 w; w.x = pk2(v0[0], v0[1]); w.y = pk2(v0[2], v0[3]); w.z = pk2(v1[0], v1[1]); w.w = pk2(v1[2], v1[3]); *(GAS_ u32x4*)(XB + off + bj * 128) = w;
                }
                ssq += __shfl_xor(ssq, 16); ssq += __shfl_xor(ssq, 32);
                if (fq == 0) *(GAS_ float*)(SS + (size_t)(row0 + ai * 128 + m * 16) * 16 + u.pn * 4 + wc) = ssq;
            }
            asm volatile("" ::: "memory");
        }
    }
};
template <int ACT> struct EpiB {
    static constexpr bool PERM = true, AFTER_DRAIN = false;
    bf16_t* O; int ldc; const float* bias;
    __device__ __forceinline__ void operator()(const f32x4 (&acc)[2][2][4][2], const Unit& u, int wr, int wc, int fr, int fq) const {
        const int row0 = u.pm * 256 + wr * 64 + fr, col0 = u.pn * 256 + wc * 32 + 8 * fq;
#pragma unroll
        for (int ai = 0; ai < 2; ++ai)
#pragma unroll
            for (int m = 0; m < 4; ++m) {
                bf16_t* rowp = O + (size_t)(row0 + ai * 128 + m * 16) * ldc + col0;
#pragma unroll
                for (int bj = 0; bj < 2; ++bj) {
                    f32x4 v0 = acc[ai][bj][m][0], v1 = acc[ai][bj][m][1];
                    if (bias) { v0 = v0 + *(const GAS_ f32x4*)(bias + col0 + bj * 128); v1 = v1 + *(const GAS_ f32x4*)(bias + col0 + bj * 128 + 4); }
                    if (ACT == 1) {
#pragma unroll
                        for (int e = 0; e < 4; ++e) { v0[e] = silu_f(v0[e]); v1[e] = silu_f(v1[e]); } }
                    u32x4 w; w.x = pk2(v0[0], v0[1]); w.y = pk2(v0[2], v0[3]); w.z = pk2(v1[0], v1[1]); w.w = pk2(v1[2], v1[3]);
                    *(GAS_ u32x4*)(rowp + bj * 128) = w;
                }
                asm volatile("" ::: "memory");
            }
    }
};
__device__ __forceinline__ int crow(int r, int hi) { return (r & 3) + 8 * (r >> 2) + 4 * hi; }
__device__ __forceinline__ float xh_max(float v) { auto rr = __builtin_amdgcn_permlane32_swap(__float_as_uint(v), __float_as_uint(v), false, false); return fmaxf(__uint_as_float(rr[0]), __uint_as_float(rr[1])); }
__device__ __forceinline__ float xh_sum(float v) { auto rr = __builtin_amdgcn_permlane32_swap(__float_as_uint(v), __float_as_uint(v), false, false); return __uint_as_float(rr[0]) + __uint_as_float(rr[1]); }
#define GAS __attribute__((address_space(1)))
__device__ __forceinline__ u32x4 ldg16(const bf16_t* p) { return *(const GAS u32x4*)p; }
__device__ __forceinline__ void tile_store(ldsp buf, const u32x4& k, const u32x4& v, int key, int ch) {
    *(LAS u32x4*)(buf + ch * 1024 + ((key ^ (2 * ch)) << 4)) = k;
    *(LAS u32x4*)(buf + 8192 + (ch >> 2) * 4096 + (key >> 4) * 1024 + (key & 15) * 64 + (ch & 3) * 16) = v;
}
__device__ __forceinline__ void q_load(bf16x8 (&qr)[4], const bf16_t* qrow, int hi) {
#pragma unroll
    for (int d0 = 0; d0 < 4; ++d0) qr[d0] = *(const GAS bf16x8*)(qrow + d0 * 16 + hi * 8);
}
__device__ __forceinline__ float max3f(float a, float b, float c) { float r; asm("v_max3_f32 %0, %1, %2, %3" : "=v"(r) : "v"(a), "v"(b), "v"(c)); return r; }
__device__ __forceinline__ void qk_tile(f32x16& p0, f32x16& p1, const ldsp Kt, const bf16x8 (&qr)[4], const f32x16& cin, int r32, int hi) {
    const ldsp kb = Kt + hi * 1024; const int ks = (r32 ^ (2 * hi)) << 4;
    __builtin_amdgcn_s_setprio(1);
#pragma unroll
    for (int d0 = 0; d0 < 4; ++d0) {
        const ldsp kp = kb + d0 * 2048 + (ks ^ (64 * d0));
        const bf16x8 b0 = *(const LAS bf16x8*)(kp), b1 = *(const LAS bf16x8*)(kp + 512);
        if (d0 == 0) { p0 = __builtin_amdgcn_mfma_f32_32x32x16_bf16(b0, qr[0], cin, 0, 0, 0); p1 = __builtin_amdgcn_mfma_f32_32x32x16_bf16(b1, qr[0], cin, 0, 0, 0); }
        else { p0 = __builtin_amdgcn_mfma_f32_32x32x16_bf16(b0, qr[d0], p0, 0, 0, 0); p1 = __builtin_amdgcn_mfma_f32_32x32x16_bf16(b1, qr[d0], p1, 0, 0, 0); }
    }
    __builtin_amdgcn_s_setprio(0);
    asm volatile("s_nop 15\n\ts_nop 7" : "+v"(p0), "+v"(p1));
}
__device__ __forceinline__ void mask_tile(f32x16& p0, f32x16& p1, int lo, int hq, int hi) {
    const bool nl = __any(lo > 0), nh = __any(hq < 63);
    if (nh && nl) {
#pragma unroll
        for (int r = 0; r < 16; ++r) { const int kk = crow(r, hi);
            if (!(kk >= lo && kk <= hq)) p0[r] = NEG_INF;
            if (!(kk + 32 >= lo && kk + 32 <= hq)) p1[r] = NEG_INF; }
    } else if (nh) {
        const int h2 = hq - 4 * hi;
#pragma unroll
        for (int r = 0; r < 16; ++r) { const int kc = (r & 3) + 8 * (r >> 2);
            if (kc > h2) p0[r] = NEG_INF;
            if (kc + 32 > h2) p1[r] = NEG_INF; }
    } else if (nl) {
        const int l2 = lo - 4 * hi;
#pragma unroll
        for (int r = 0; r < 16; ++r) { const int kc = (r & 3) + 8 * (r >> 2);
            if (kc < l2) p0[r] = NEG_INF;
            if (kc + 32 < l2) p1[r] = NEG_INF; }
    }
}
__device__ __forceinline__ float tile_max(const f32x16& p0, const f32x16& p1) {
    float a = max3f(p0[0], p0[1], p1[0]), b = max3f(p0[2], p0[3], p1[1]); a = max3f(a, p1[2], p1[3]);
#pragma unroll
    for (int r = 4; r < 16; r += 4) { a = max3f(a, p0[r], p0[r + 1]); b = max3f(b, p0[r + 2], p0[r + 3]); a = max3f(a, p1[r], p1[r + 1]); b = max3f(b, p1[r + 2], p1[r + 3]); }
    return xh_max(max3f(a, b, b));
}
__device__ __forceinline__ void splat16(f32x16& v, float x) {
#pragma unroll
    for (int r = 0; r < 16; ++r) v[r] = x;
    asm volatile("" : "+v"(v));
}
constexpr float SM_THR = 6.0f;
__device__ __forceinline__ void sm_update(f32x16& p0, f32x16& p1, float& mref, f32x16& negm, float& l, f32x16 (&o)[2], bool first, LAS float* wsf, int r32, int hi) {
    const float rm = tile_max(p0, p1);
    if (first || __any(rm > SM_THR)) {
        const float dl = first ? ((rm == NEG_INF) ? 0.f : rm) : fmaxf(rm, 0.f);
        mref += dl;
#pragma unroll
        for (int r = 0; r < 16; ++r) { p0[r] -= dl; p1[r] -= dl; }
        splat16(negm, -mref);
        if (!first) {
            const float f = fexp2(-dl);
            l *= f;
            if (hi == 0) wsf[r32] = f;
            LDS_WAIT();
#pragma unroll
            for (int r = 0; r < 16; ++r) { const float g = wsf[crow(r, hi)]; o[0][r] *= g; o[1][r] *= g; }
            LDS_WAIT();
        }
    }
    float s = 0.f;
#pragma unroll
    for (int r = 0; r < 16; ++r) { p0[r] = fexp2(p0[r]); p1[r] = fexp2(p1[r]); s += p0[r] + p1[r]; }
    l += s;
}
__device__ __forceinline__ s16x4 vtr(const ldsp p) { typedef short v4i16_t __attribute__((ext_vector_type(4))); return __builtin_bit_cast(s16x4, __builtin_amdgcn_ds_read_tr16_b64_v4i16((LAS v4i16_t*)p)); }
__device__ __forceinline__ void pv_tile(f32x16 (&o)[2], const ldsp Vt, const f32x16& p0, const f32x16& p1, int lane, int hi) {
    u32x4 pw[4];
    pw[0] = (u32x4){pk2(p0[0], p0[1]), pk2(p0[2], p0[3]), pk2(p0[4], p0[5]), pk2(p0[6], p0[7])};
    pw[1] = (u32x4){pk2(p0[8], p0[9]), pk2(p0[10], p0[11]), pk2(p0[12], p0[13]), pk2(p0[14], p0[15])};
    pw[2] = (u32x4){pk2(p1[0], p1[1]), pk2(p1[2], p1[3]), pk2(p1[4], p1[5]), pk2(p1[6], p1[7])};
    pw[3] = (u32x4){pk2(p1[8], p1[9]), pk2(p1[10], p1[11]), pk2(p1[12], p1[13]), pk2(p1[14], p1[15])};
    const ldsp vp = Vt + ((lane >> 4) & 1) * 32 + (lane & 3) * 8 + (4 * hi + ((lane & 15) >> 2)) * 64;
    __builtin_amdgcn_s_setprio(1);
#pragma unroll
    for (int d0 = 0; d0 < 2; ++d0)
#pragma unroll
        for (int ks = 0; ks < 4; ++ks) {
            const s16x4 lo = vtr(vp + d0 * 4096 + ks * 1024), hh = vtr(vp + d0 * 4096 + ks * 1024 + 512);
            const bf16x8 vf = (bf16x8){lo[0], lo[1], lo[2], lo[3], hh[0], hh[1], hh[2], hh[3]};
            o[d0] = __builtin_amdgcn_mfma_f32_32x32x16_bf16(__builtin_bit_cast(bf16x8, pw[ks]), vf, o[d0], 0, 0, 0);
        }
    __builtin_amdgcn_s_setprio(0);
}
__device__ __forceinline__ void attn_step(const ldsp Kt, const ldsp Vt, const bf16x8 (&qr)[4], f32x16 (&o)[2], float& mref, f32x16& negm, float& l, int lo, int hq, bool en, bool first, LAS float* wsf, int lane, int r32, int hi) {
    f32x16 p0, p1;
    qk_tile(p0, p1, Kt, qr, negm, r32, hi);
    if (!__all(en)) { const float pen = en ? 0.f : NEG_INF;
#pragma unroll
        for (int r = 0; r < 16; ++r) { p0[r] += pen; p1[r] += pen; } }
    mask_tile(p0, p1, lo, hq, hi);
    sm_update(p0, p1, mref, negm, l, o, first, wsf, r32, hi);
    pv_tile(o, Vt, p0, p1, lane, hi);
}
__device__ __forceinline__ void rows_axpy(f32x16 (&acc)[2], const f32x16 (&o)[2], float f, LAS float* wsf, int r32, int hi, bool init) {
    LDS_WAIT();
    if (hi == 0) wsf[r32] = f;
    LDS_WAIT();
#pragma unroll
    for (int r = 0; r < 16; ++r) { const float g = wsf[crow(r, hi)];
        if (init) { acc[0][r] = o[0][r] * g; acc[1][r] = o[1][r] * g; } else { acc[0][r] += o[0][r] * g; acc[1][r] += o[1][r] * g; } }
    LDS_WAIT();
}

template <class F> __device__ __forceinline__ void stage_store(const f32x16 (&ot)[2], ldsp lds, int w, int lane, int r32, int hi, F rowp) {
    LAS float* stg = (LAS float*)(lds + 65536 + w * 8704);
#pragma unroll
    for (int d0 = 0; d0 < 2; ++d0)
#pragma unroll
        for (int r = 0; r < 16; ++r) stg[crow(r, hi) * 68 + d0 * 32 + r32] = ot[d0][r];
    LDS_WAIT();
#pragma unroll
    for (int i = 0; i < 4; ++i) {
        const int row = i * 8 + (lane >> 3);
        const f32x4 x0 = *(const LAS f32x4*)(stg + row * 68 + (lane & 7) * 8), x1 = *(const LAS f32x4*)(stg + row * 68 + (lane & 7) * 8 + 4);
        u32x4 ow; ow.x = pk2(x0[0], x0[1]); ow.y = pk2(x0[2], x0[3]); ow.z = pk2(x1[0], x1[1]); ow.w = pk2(x1[2], x1[3]);
        *(GAS u32x4*)(rowp(row) + (lane & 7) * 8) = ow;
    }
    LDS_WAIT();
}

__device__ __forceinline__ void b_unit(const bf16_t* Z, bf16_t* MIX, const float* sinks, ldsp lds, int b, int kvh, int qb, unsigned& gt, int wave0) {
    int tid_; asm volatile("v_mbcnt_lo_u32_b32 %0, -1, 0\n\tv_mbcnt_hi_u32_b32 %0, -1, %0" : "=&v"(tid_)); tid_ += wave0 * 64; const int tid = tid_, lane = tid & 63, w = __builtin_amdgcn_readfirstlane(tid >> 6), r32 = lane & 31, hi = lane >> 5;
    const int g = r32 >> 3, qq = r32 & 7, tq = 64 * qb + 8 * w + qq, head = kvh * 4 + g, key = tid >> 3, ch = tid & 7;
    LAS float* wsf = (LAS float*)(lds + LDS_WSF) + w * 64;
    const size_t tok = (size_t)b * T + tq;
    bf16x8 qr[4]; q_load(qr, Z + tok * ZP0 + C_BQ + head * 64, hi);
    float m = *(const GAS float*)(sinks + head) * LOG2E, l = (hi == 0) ? 1.f : 0.f;
    f32x16 o[2], negm; splat16(negm, -m);
    splat16(o[0], 0.f); splat16(o[1], 0.f);
    const int n0 = qb >= 2 ? qb - 2 : 0;
    const bf16_t* kvp = Z + ((size_t)b * T + key) * ZP0 + kvh * 64 + ch * 8;
    u32x4 rk0 = ldg16(kvp + (size_t)(64 * n0) * ZP0 + C_BK), rv0 = ldg16(kvp + (size_t)(64 * n0) * ZP0 + C_BV), rk1 = rk0, rv1 = rv0;
    if (n0 + 1 <= qb) { rk1 = ldg16(kvp + (size_t)(64 * (n0 + 1)) * ZP0 + C_BK); rv1 = ldg16(kvp + (size_t)(64 * (n0 + 1)) * ZP0 + C_BV); }
    tile_store(lds + (gt & 1u) * 16384, rk0, rv0, key, ch);
    if (n0 + 2 <= qb) { rk0 = ldg16(kvp + (size_t)(64 * (n0 + 2)) * ZP0 + C_BK); rv0 = ldg16(kvp + (size_t)(64 * (n0 + 2)) * ZP0 + C_BV); }
    __syncthreads();
#define B_STEP(n, RK, RV) do { \
        const ldsp buf = lds + (gt & 1u) * 16384, nxt = lds + ((gt + 1u) & 1u) * 16384; \
        if ((n) < qb) tile_store(nxt, RK, RV, key, ch); \
        if ((n) + 3 <= qb) { RK = ldg16(kvp + (size_t)(64 * ((n) + 3)) * ZP0 + C_BK); RV = ldg16(kvp + (size_t)(64 * ((n) + 3)) * ZP0 + C_BV); } \
        attn_step(buf, buf + 8192, qr, o, m, negm, l, tq - 127 - 64 * (n), tq - 64 * (n), true, false, wsf, lane, r32, hi); \
        __syncthreads(); ++gt; } while (0)
    for (int n = n0; n <= qb; n += 2) { B_STEP(n, rk1, rv1); if (n + 1 <= qb) B_STEP(n + 1, rk0, rv0); }
#undef B_STEP
    const float lt = xh_sum(l);
    f32x16 ot[2];
    rows_axpy(ot, o, 1.0f / lt, wsf, r32, hi, true);
    stage_store(ot, lds, w, lane, r32, hi, [=](int q) { return MIX + ((size_t)b * T + 64 * qb + 8 * w + (q & 7)) * 1024 + 512 + (kvh * 4 + (q >> 3)) * 64; });
}

__device__ __forceinline__ void nsa_unit(const bf16_t* Z, const bf16_t* KVC, bf16_t* MIX, ldsp lds, int b, int kvh, int qb, unsigned& gt, int wave0) {
    int tid_; asm volatile("v_mbcnt_lo_u32_b32 %0, -1, 0\n\tv_mbcnt_hi_u32_b32 %0, -1, %0" : "=&v"(tid_)); tid_ += wave0 * 64; const int tid = tid_, lane = tid & 63, w = __builtin_amdgcn_readfirstlane(tid >> 6), r32 = lane & 31, hi = lane >> 5;
    const int g = r32 >> 3, qq = r32 & 7, tq = 64 * qb + 8 * w + qq, head = kvh * 4 + g, key = tid >> 3, ch = tid & 7;
    LAS float* wsf = (LAS float*)(lds + LDS_WSF) + w * 64;
    const size_t tok = (size_t)b * T + tq;
    const bf16_t* zrow = Z + tok * ZP0;
    const int nct = (4 * qb + 3 + 63) >> 6;
    {
        const bf16_t* kv = KVC + ((size_t)(b * 2 + kvh) * 256 + key) * 512 + ch * 8;
        for (int ct = 0; ct < nct; ++ct) { const u32x4 k = ldg16(kv + (size_t)ct * 64 * 512), v = ldg16(kv + (size_t)ct * 64 * 512 + 256); tile_store(lds + ct * 16384, k, v, key, ch); }
    }
    const GAS bf16_t* zg = (const GAS bf16_t*)(zrow + C_GATE + head * 3);
    const unsigned gpk = (unsigned)zg[0] | ((unsigned)zg[1] << 16), gp2 = (unsigned)zg[2];
#define GATE0() sigmoid_f(__builtin_bit_cast(float, gpk << 16))
#define GATE1() sigmoid_f(__builtin_bit_cast(float, gpk & 0xffff0000u))
#define GATE2() sigmoid_f(__builtin_bit_cast(float, gp2 << 16))
    bf16x8 qr[4]; q_load(qr, zrow + C_AQP + head * 64, hi);
    __syncthreads();
    float m = 0.f, l = 0.f;
    f32x16 o[2], ot[2], negm; splat16(negm, 0.f);
    splat16(o[0], 0.f); splat16(o[1], 0.f);
    const int cmax = (tq - 31) >> 4;
    for (int ct = 0; ct < nct; ++ct) attn_step(lds + ct * 16384, lds + ct * 16384 + 8192, qr, o, m, negm, l, 0, cmax - 64 * ct, true, ct == 0, wsf, lane, r32, hi);
    const float ltc = xh_sum(l), inv = ltc > 0.f ? 1.0f / ltc : 0.f;
    unsigned long long selmask = ~0ull;
    if (qb >= 16) {
        LAS float* G = (LAS float*)(lds + LDS_NSA_IMP + w * NSA_IMP_STRIDE); LAS float* L = G + 512;
        for (int ct = 0; ct < nct; ++ct) {
            f32x16 p0, p1;
            qk_tile(p0, p1, lds + ct * 16384, qr, negm, r32, hi);
            mask_tile(p0, p1, 0, cmax - 64 * ct, hi);
#pragma unroll
            for (int r = 0; r < 16; ++r) { p0[r] = fexp2(p0[r]) * inv; p1[r] = fexp2(p1[r]) * inv; }
#pragma unroll
            for (int hf = 0; hf < 2; ++hf)
#pragma unroll
                for (int grp = 0; grp < 4; ++grp) {
                    float gs, ls;
                    if (hf == 0) { gs = (p0[4 * grp] + p0[4 * grp + 1]) + (p0[4 * grp + 2] + p0[4 * grp + 3]); ls = p0[4 * grp + 3]; }
                    else         { gs = (p1[4 * grp] + p1[4 * grp + 1]) + (p1[4 * grp + 2] + p1[4 * grp + 3]); ls = p1[4 * grp + 3]; }
                    gs += __shfl_xor(gs, 8); gs += __shfl_xor(gs, 16); ls += __shfl_xor(ls, 8); ls += __shfl_xor(ls, 16);
                    const int n = ct * 16 + hf * 8 + 2 * grp + hi;
                    if (g == 0) { G[qq * 64 + n] = gs; L[qq * 68 + n + 1] = ls; }
                }
        }
        LDS_WAIT();
#pragma unroll 1
        for (int q8 = 0; q8 < 8; ++q8) {
            float v = G[q8 * 64 + lane] + (lane > 0 ? L[q8 * 68 + lane] : 0.f);
            v = (lane > qb) ? -1.f : v;
            v = (lane == 0) ? 3e38f : (lane == qb) ? 2e38f : (lane == qb - 1) ? 1e38f : v;
            int rank = 0;
#pragma unroll
            for (int j = 0; j < 64; ++j) { const float vj = __uint_as_float(__builtin_amdgcn_readlane(__float_as_uint(v), j)); rank += (vj > v) ? 1 : 0; }
            const unsigned long long mk = __ballot(rank < 16);
            if (qq == q8) selmask = mk;
        }
    }
    rows_axpy(ot, o, GATE0() * inv, wsf, r32, hi, true);
    q_load(qr, zrow + C_AQR + head * 64, hi);
    const int ns = qb + 1, w0 = qb >= 8 ? qb - 8 : 0, ntile = ns + (qb - w0 + 1);
    m = 0.f; l = 0.f; splat16(negm, 0.f);
    splat16(o[0], 0.f); splat16(o[1], 0.f);
    const bf16_t* kvp = Z + ((size_t)b * T + key) * ZP0 + kvh * 64 + ch * 8;
#define NSA_LOAD(j, RK, RV) do { const bool nw_ = (j) >= ns; const int nn_ = nw_ ? w0 + (j) - ns : (j); \
        RK = ldg16(kvp + (size_t)(64 * nn_) * ZP0 + (nw_ ? C_AKW : C_AKS)); RV = ldg16(kvp + (size_t)(64 * nn_) * ZP0 + (nw_ ? C_AVW : C_AVS)); } while (0)
    u32x4 rk0, rv0, rk1, rv1;
    NSA_LOAD(0, rk0, rv0); NSA_LOAD(1, rk1, rv1);
    tile_store(lds + LDS_NSA_RING + (gt & 1u) * 16384, rk0, rv0, key, ch);
    if (2 < ntile) NSA_LOAD(2, rk0, rv0);
    __syncthreads();
    LAS float* slab = (LAS float*)(lds + w * 8192) + lane;
#pragma unroll
    for (int k = 0; k < 16; ++k) { slab[k * 64] = ot[0][k]; slab[(16 + k) * 64] = ot[1][k]; }
#define NSA_STEP(i, RK, RV) do { \
        const bool isw = (i) >= ns; const int n = isw ? w0 + (i) - ns : (i); \
        const ldsp buf = lds + LDS_NSA_RING + (gt & 1u) * 16384, nxt = lds + LDS_NSA_RING + ((gt + 1u) & 1u) * 16384; \
        if ((i) + 1 < ntile) tile_store(nxt, RK, RV, key, ch); \
        if ((i) + 3 < ntile) NSA_LOAD((i) + 3, RK, RV); \
        if ((i) == ns) { \
            const float lt = xh_sum(l); f32x16 t2[2]; \
            rows_axpy(t2, o, GATE1() / lt, wsf, r32, hi, true); \
            _Pragma("unroll") for (int k = 0; k < 16; ++k) { slab[k * 64] += t2[0][k]; slab[(16 + k) * 64] += t2[1][k]; } \
            m = 0.f; l = 0.f; splat16(negm, 0.f); \
            splat16(o[0], 0.f); splat16(o[1], 0.f); \
        } \
        const bool en = isw ? true : (((selmask >> n) & 1ull) != 0ull); \
        const int lo = isw ? tq - 511 - 64 * n : 0, hq = tq - 64 * n; \
        if (__any(en)) attn_step(buf, buf + 8192, qr, o, m, negm, l, lo, hq, en, (i) == 0 || (i) == ns, wsf, lane, r32, hi); \
        __syncthreads(); ++gt; } while (0)
    for (int i = 0; i < ntile; i += 2) { NSA_STEP(i, rk1, rv1); if (i + 1 < ntile) NSA_STEP(i + 1, rk0, rv0); }
#undef NSA_STEP
#undef NSA_LOAD
    {
        const float lt = xh_sum(l);
        rows_axpy(ot, o, GATE2() / lt, wsf, r32, hi, true);
#pragma unroll
        for (int k = 0; k < 16; ++k) { ot[0][k] += slab[k * 64]; ot[1][k] += slab[(16 + k) * 64]; }
    }
    stage_store(ot, lds, w, lane, r32, hi, [=](int q) { return MIX + ((size_t)b * T + 64 * qb + 8 * w + (q & 7)) * 1024 + (kvh * 4 + (q >> 3)) * 64; });
    __syncthreads();
#undef GATE0
#undef GATE1
#undef GATE2
}

__device__ __forceinline__ void c_phase(const bf16_t* Z, bf16_t* MIX, float* LSE, ldsp lds, int pi, int bx, int G, unsigned& gt, int wave0, int ucount) {
    int tid_; asm volatile("v_mbcnt_lo_u32_b32 %0, -1, 0\n\tv_mbcnt_hi_u32_b32 %0, -1, %0" : "=&v"(tid_)); tid_ += wave0 * 64; const int tid = tid_, lane = tid & 63, w = __builtin_amdgcn_readfirstlane(tid >> 6), r32 = lane & 31, hi = lane >> 5;
    const int hsel = w >> 2, gq = (w < 4) ? w : 7 - w, key = tid >> 3, ch = tid & 7;
    const int ldil = 2 * pi, dil = 1 << ldil, lnb = 5 - ldil;
    LAS float* wsf = (LAS float*)(lds + LDS_WSF) + w * 64;
    const size_t tstride = (size_t)64 * dil * 64;
    const unsigned kvlane = (unsigned)(key * dil * 64 + ch * 8), qlane = (unsigned)(r32 * dil * 64), olane = (unsigned)((lane >> 3) * dil * 1024 + (lane & 7) * 8), llane = (unsigned)(r32 * dil * 16);
#define C_DEC(u_, b_, hp_, rs_, blk_) const int blk_ = (u_) & ((1 << lnb) - 1), rs_ = ((u_) >> lnb) & (dil - 1), hp_ = ((u_) >> 5) & 7, b_ = (u_) >> 8
#define C_KVP(b_, hp_, rs_) (Z + ((size_t)(((b_) * 3 + 1) * 16 + 2 * (hp_)) * T + (rs_)) * 64)
#define C_QROW(b_, hp_, rs_, blk_) (Z + ((size_t)(((b_) * 3) * 16 + 2 * (hp_) + hsel) * T + (size_t)(128 * (blk_) + 32 * gq) * dil + (rs_)) * 64 + qlane)
#define C_LOADP(p_) do { const bf16_t* q_ = (p_); rka = ldg16(q_ + kvlane); rva = ldg16(q_ + (size_t)16 * T * 64 + kvlane); rkb = ldg16(q_ + (size_t)T * 64 + kvlane); rvb = ldg16(q_ + (size_t)17 * T * 64 + kvlane); } while (0)
    const u32x4 z4 = {0u, 0u, 0u, 0u};
    u32x4 rka = z4, rva = z4, rkb = z4, rvb = z4;
    const int per = (ucount + G - 1) / G, uend = (bx + 1) * per < ucount ? (bx + 1) * per : ucount;
    int u = bx * per;
    if (u >= uend) return;
    {   C_DEC(u, b, hp, rs, blk); const int kt0 = blk >= 1 ? 2 * blk - 2 : 0; const bf16_t* kvp = C_KVP(b, hp, rs);
        C_LOADP(kvp + kt0 * tstride);
        { const ldsp b0 = lds + (gt & 1u) * 32768; tile_store(b0, rka, rva, key, ch); tile_store(b0 + 16384, rkb, rvb, key, ch); }
        C_LOADP(kvp + (kt0 + 1) * tstride);
        __syncthreads(); }
    for (; u < uend; ++u) {
        C_DEC(u, b, hp, rs, blk);
        const int head = 2 * hp + hsel, q0 = 128 * blk + 32 * gq, ql = q0 + r32;
        const int kt0 = blk >= 1 ? 2 * blk - 2 : 0, kt1 = 2 * blk + 1;
        const bf16_t* kvp = C_KVP(b, hp, rs);
        const bool has_next = u + 1 < uend;
        const int un = has_next ? u + 1 : u;
        C_DEC(un, bn, hpn, rsn, blkn);
        const int kt0n = blkn >= 1 ? 2 * blkn - 2 : 0;
        const bf16_t* kvpn = C_KVP(bn, hpn, rsn) + kt0n * tstride;
        bf16x8 qr[4]; q_load(qr, C_QROW(b, hp, rs, blk), hi);
        GAS float* lsep = (GAS float*)(LSE + ((size_t)b * T + (size_t)q0 * dil + rs) * 16 + head + llane);
        bf16_t* orow = MIX + ((size_t)b * T + (size_t)q0 * dil + rs) * 1024 + head * 64 + olane;
        const size_t ostep = (size_t)8 * dil * 1024;
        u32x4 orun[4] = {z4, z4, z4, z4}; float lse_old = 0.f;
        float m = 0.f, l = 0.f; bool started = false;
        f32x16 o[2], negm; splat16(negm, 0.f);
        splat16(o[0], 0.f); splat16(o[1], 0.f);
        for (int kt = kt0; kt <= kt1; ++kt) {
            const ldsp buf = lds + (gt & 1u) * 32768, nxt = lds + ((gt + 1u) & 1u) * 32768;
            if (kt == kt1 - 1) {
                if (pi > 0) { lse_old = *lsep;
#pragma unroll
                    for (int i = 0; i < 4; ++i) orun[i] = ldg16(orow + i * ostep); }
            }
            if (64 * kt <= q0 + 31 && 64 * kt + 63 >= q0 - 128) {
                attn_step(buf + hsel * 16384, buf + hsel * 16384 + 8192, qr, o, m, negm, l, ql - 128 - 64 * kt, ql - 64 * kt, true, !started, wsf, lane, r32, hi); started = true; }
            if (kt < kt1 || has_next) { tile_store(nxt, rka, rva, key, ch); tile_store(nxt + 16384, rkb, rvb, key, ch); }
            if (kt + 2 <= kt1) C_LOADP(kvp + (kt + 2) * tstride);
            else if (has_next) { if (kt == kt1 - 1) C_LOADP(kvpn); else C_LOADP(kvpn + tstride); }
            __syncthreads(); ++gt;
        }
        const float lt = xh_sum(l), lse = m + __log2f(lt);
        float wa = 0.f, wb = 1.0f / lt;
        if (pi > 0) {
            const float mx = fmaxf(lse_old, lse), nl = mx + __log2f(fexp2(lse_old - mx) + fexp2(lse - mx));
            wa = fexp2(lse_old - nl); wb = fexp2(lse - nl) / lt;
            if (pi < 2 && hi == 0) *lsep = nl;
        } else if (hi == 0) *lsep = lse;
        LDS_WAIT();
        if (hi == 0) { wsf[r32] = wa; wsf[32 + r32] = wb; }
        LDS_WAIT();
        LAS float* stg = (LAS float*)(lds + 65536 + w * 8704);
#pragma unroll
        for (int d0 = 0; d0 < 2; ++d0)
#pragma unroll
            for (int r = 0; r < 16; ++r) { const int q = crow(r, hi); stg[q * 68 + d0 * 32 + r32] = wsf[32 + q] * o[d0][r]; }
        LDS_WAIT();
#pragma unroll
        for (int i = 0; i < 4; ++i) {
            const int row = i * 8 + (lane >> 3);
            const f32x4 x0 = *(const LAS f32x4*)(stg + row * 68 + (lane & 7) * 8), x1 = *(const LAS f32x4*)(stg + row * 68 + (lane & 7) * 8 + 4);
            float v[8] = {x0[0], x0[1], x0[2], x0[3], x1[0], x1[1], x1[2], x1[3]};
            if (pi > 0) { const float fa = wsf[row];
#pragma unroll
                for (int k = 0; k < 4; ++k) { const unsigned wd = orun[i][k]; v[2 * k] += fa * __builtin_bit_cast(float, wd << 16); v[2 * k + 1] += fa * __builtin_bit_cast(float, wd & 0xffff0000u); } }
            u32x4 ow; ow.x = pk2(v[0], v[1]); ow.y = pk2(v[2], v[3]); ow.z = pk2(v[4], v[5]); ow.w = pk2(v[6], v[7]);
            *(GAS u32x4*)(orow + i * ostep) = ow;
        }
        LDS_WAIT();
    }
#undef C_DEC
#undef C_KVP
#undef C_QROW
#undef C_LOADP
}
__device__ __forceinline__ int il64(int p) { return (p & 1) ? (p >> 1) + 32 : (p >> 1); }
__device__ __forceinline__ int src_col(int mapid, int n) {
    switch (mapid) {
    case 0:
        if (n < 512) return (n & ~63) + il64(n & 63);
        if (n < 768) return n;
        if (n < 896) return (n & ~63) + il64(n & 63);
        if (n < 1024) return n;
        if (n < 1152) return (n & ~63) + il64(n & 63);
        if (n < 1280) return n;
        if (n < 1792) { const int q = n - 1280; return 1304 + (q & ~63) + il64(q & 63); }
        if (n < 1920) { const int q = n - 1792; return 1816 + (q & ~63) + il64(q & 63); }
        if (n < 2048) return 1944 + (n - 1920);
        if (n < 2072) return 1280 + (n - 2048);
        return -1;
    case 2: return n < 2048 ? (n & ~63) + il64(n & 63) : n;
    case 3: { const int hid = (n >> 8) * 128 + (n & 127); return ((n >> 7) & 1) ? FF + hid : hid; }
    case 4: return n < 64 ? il64(n) : -1;
    case 5: return n < 64 ? n : -1;
    default: return n;
    }
}
__device__ __forceinline__ void tr_item(const float* W, int K, int Nlog, const float* gain, bf16_t* Wt, int mapid, int nblk, LAS float* scr, int item, int lane) {
    const int kb = item / nblk, nb = item % nblk, k0 = 64 * kb, n0 = 32 * nb;
    const int src = src_col(mapid, n0 + (lane & 31));
#pragma unroll 8
    for (int i = 0; i < 32; ++i) { const int kk = 2 * i + (lane >> 5); float v = 0.f;
        if (src >= 0) { v = *(const GAS float*)(W + (size_t)(k0 + kk) * Nlog + src); if (gain) v *= *(const GAS float*)(gain + k0 + kk); }
        scr[kk * 33 + (lane & 31)] = v; }
    LDS_WAIT();
    const int c = lane & 7;
#pragma unroll
    for (int j = 0; j < 4; ++j) { const int n = (lane >> 3) + 8 * j; const LAS float* s = scr + (8 * c) * 33 + n;
        u32x4 o; o.x = pk2(s[0 * 33], s[1 * 33]); o.y = pk2(s[2 * 33], s[3 * 33]); o.z = pk2(s[4 * 33], s[5 * 33]); o.w = pk2(s[6 * 33], s[7 * 33]);
        *(GAS u32x4*)(Wt + (size_t)(n0 + n) * K + k0 + 8 * c) = o; }
    LDS_WAIT();
}
__device__ __forceinline__ void row_to_bf16_ss(const float* xrow, bf16_t* orow, float* ssrow, int lane) {
    const GAS f32x4* xr = (const GAS f32x4*)xrow + 2 * lane;
    f32x4 v[4]; float s = 0.f;
#pragma unroll
    for (int j = 0; j < 2; ++j) { v[2 * j] = xr[128 * j]; v[2 * j + 1] = xr[128 * j + 1]; }
#pragma unroll
    for (int j = 0; j < 4; ++j) s += (v[j].x * v[j].x + v[j].y * v[j].y) + (v[j].z * v[j].z + v[j].w * v[j].w);
    s = wave_sum(s);
    GAS u32x4* o16 = (GAS u32x4*)orow + lane;
#pragma unroll
    for (int j = 0; j < 2; ++j) { u32x4 w; w.x = pk2(v[2 * j].x, v[2 * j].y); w.y = pk2(v[2 * j].z, v[2 * j].w); w.z = pk2(v[2 * j + 1].x, v[2 * j + 1].y); w.w = pk2(v[2 * j + 1].z, v[2 * j + 1].w); o16[64 * j] = w; }
    if (lane < 16) *(GAS float*)(ssrow + lane) = (lane == 0) ? s : 0.f;
}
__device__ __forceinline__ void rms_row_final(const bf16_t* xbrow, float* orow, const float* gain, const float* ssrow, int lane) {
    GAS f32x4* xo = (GAS f32x4*)orow + 2 * lane; const GAS f32x4* gr = (const GAS f32x4*)gain + 2 * lane; const GAS u32x4* xr = (const GAS u32x4*)xbrow + lane;
    u32x4 h[2];
#pragma unroll
    for (int j = 0; j < 2; ++j) h[j] = xr[64 * j];
    const float s = lane < 16 ? *(const GAS float*)(ssrow + lane) : 0.f;
    const float rstd = 1.0f / sqrtf(wave_sum(s) * (1.0f / D) + NORM_EPS);
#pragma unroll
    for (int j = 0; j < 2; ++j) {
        const f32x4 a = (f32x4){__builtin_bit_cast(float, h[j].x << 16), __builtin_bit_cast(float, h[j].x & 0xffff0000u), __builtin_bit_cast(float, h[j].y << 16), __builtin_bit_cast(float, h[j].y & 0xffff0000u)};
        const f32x4 b = (f32x4){__builtin_bit_cast(float, h[j].z << 16), __builtin_bit_cast(float, h[j].z & 0xffff0000u), __builtin_bit_cast(float, h[j].w << 16), __builtin_bit_cast(float, h[j].w & 0xffff0000u)};
        xo[128 * j] = (a * rstd) * gr[128 * j]; xo[128 * j + 1] = (b * rstd) * gr[128 * j + 1]; }
}
__device__ __forceinline__ void sincos_d(float a, float& c, float& s) {
    const double x = (double)a; const double kq = __builtin_rint(x * 0.63661977236758134308);
    double r = __builtin_fma(-kq, 1.57079632679489655800, x); r = __builtin_fma(-kq, 6.12323399573676603587e-17, r);
    const double r2 = r * r;
    const double sn = r * (1.0 + r2 * (-1.0 / 6 + r2 * (1.0 / 120 + r2 * (-1.0 / 5040 + r2 * (1.0 / 362880 + r2 * (-1.0 / 39916800 + r2 * (1.0 / 6227020800.0)))))));
    const double cs = 1.0 + r2 * (-0.5 + r2 * (1.0 / 24 + r2 * (-1.0 / 720 + r2 * (1.0 / 40320 + r2 * (-1.0 / 3628800 + r2 * (1.0 / 479001600.0 + r2 * (-1.0 / 87178291200.0)))))));
    const int q = (int)kq & 3;
    const double so = (q == 0) ? sn : (q == 1) ? cs : (q == 2) ? -sn : -cs, co = (q == 0) ? cs : (q == 1) ? -sn : (q == 2) ? -cs : sn;
    c = (float)co; s = (float)so;
}

typedef unsigned v4u __attribute__((ext_vector_type(4)));
#define XB_TMO      128
#define XB_XCNT(j)  (256  + 64 * (j))
#define XB_XSUB(j)  (1280 + 64 * (j))
#define XB_XGEN(j)  (2304 + 64 * (j))
#define XB_TOP      3328
#define XB_TOPGEN   3392
#define XCD_BAR_WORDS 3456
#define XB_SPIN_CAP (1u << 18)

__device__ __forceinline__ unsigned xb_ld(unsigned* p)              { return __hip_atomic_load(p, __ATOMIC_RELAXED, __HIP_MEMORY_SCOPE_AGENT); }
__device__ __forceinline__ unsigned xb_add(unsigned* p, unsigned v) { return __hip_atomic_fetch_add(p, v, __ATOMIC_RELAXED, __HIP_MEMORY_SCOPE_AGENT); }
__device__ __forceinline__ unsigned xb_xcc_id() { return (unsigned)__builtin_amdgcn_s_getreg((3 << 11) | 20) & 0xFu; }
#define XB_SPIN(cond, bar) do { unsigned _sp = 0; while (cond) { __builtin_amdgcn_s_sleep(1); \
    if ((++_sp & 255u) == 0u) { if (xb_ld(&(bar)[XB_TMO])) break; if (_sp > XB_SPIN_CAP) { atomicAdd(&(bar)[XB_TMO], 1u); break; } } } } while (0)

struct XcdBarrier {
    unsigned* bar; unsigned x; int w0;
    volatile LAS unsigned* st;
};

__device__ __forceinline__ bool xb_thread0(int w0) { return w0 == 0 && __builtin_amdgcn_mbcnt_hi(~0u, __builtin_amdgcn_mbcnt_lo(~0u, 0u)) == 0u; }
__device__ __forceinline__ XcdBarrier xcd_barrier_post(unsigned* bar, volatile LAS unsigned* st, int w0) {
    XcdBarrier b; b.bar = bar; b.x = xb_xcc_id(); b.st = st; b.w0 = w0;
    if (xb_thread0(w0)) (void)xb_add(&bar[XB_XCNT(b.x)], 1u);
    return b;
}
__device__ __forceinline__ void xcd_barrier_complete(unsigned* bar, unsigned x, unsigned& nloc, unsigned& nx) {
    const unsigned G = gridDim.x * gridDim.y * gridDim.z;
    unsigned sum, cnt, mine, sp = 0u;
    for (;;) {
        sum = 0u; cnt = 0u; mine = 0u;
#pragma unroll
        for (unsigned j = 0; j < 16; ++j) { const unsigned c = xb_ld(&bar[XB_XCNT(j)]); sum += c; cnt += (c > 0u) ? 1u : 0u; mine = (j == x) ? c : mine; }
        if (sum == G) break;
        __builtin_amdgcn_s_sleep(1);
        if ((++sp & 255u) == 0u) { if (xb_ld(&bar[XB_TMO])) break; if (sp > XB_SPIN_CAP) { atomicAdd(&bar[XB_TMO], 1u); break; } }
    }
    nloc = mine > 0u ? mine : 1u; nx = cnt > 0u ? cnt : 1u;
}

__device__ __forceinline__ void xcd_barrier(const XcdBarrier& b) {
    asm volatile("s_waitcnt vmcnt(0)" ::: "memory");
    __syncthreads();
    if (xb_thread0(b.w0)) {
        unsigned* bar = b.bar;
        __builtin_amdgcn_s_waitcnt(0);
        unsigned nloc = b.st[0], nx = b.st[1];
        if (nloc == 0u) { xcd_barrier_complete(bar, b.x, nloc, nx); b.st[0] = nloc; b.st[1] = nx; }
        const unsigned old = xb_add(&bar[XB_XSUB(b.x)], 1u);
        const unsigned gen = old / nloc;
        if (old + 1u == (gen + 1u) * nloc) {
            __builtin_amdgcn_fence(__ATOMIC_RELEASE, "agent");
            asm volatile("s_waitcnt vmcnt(0)" ::: "memory");
            const unsigned og = xb_add(&bar[XB_TOP], 1u);
            const unsigned tg = og / nx;
            if (og + 1u == (tg + 1u) * nx) xb_add(&bar[XB_TOPGEN], 1u);
            else XB_SPIN(xb_ld(&bar[XB_TOPGEN]) == tg, bar);
            __builtin_amdgcn_fence(__ATOMIC_ACQUIRE, "agent");
            xb_add(&bar[XB_XGEN(b.x)], 1u);
            asm volatile("s_waitcnt vmcnt(0)" ::: "memory");
        } else {
            XB_SPIN(xb_ld(&bar[XB_XGEN(b.x)]) == gen, bar);
            __builtin_amdgcn_fence(__ATOMIC_ACQUIRE, "agent");
            asm volatile("s_waitcnt vmcnt(0)" ::: "memory");
        }
    }
    __syncthreads();
}

__global__ void __launch_bounds__(512, 2) fwd_mega(Params P) {
    extern __shared__ __attribute__((aligned(16))) unsigned char lds_raw[];
    cg::grid_group grid = cg::this_grid();
    const ldsp lds = (ldsp)lds_raw;
    const int G = gridDim.x, bx = blockIdx.x, NGW = G * 8;
    const int wave0 = __builtin_amdgcn_readfirstlane((int)threadIdx.x >> 6);
#define TID_SETUP() int tid_; asm volatile("v_mbcnt_lo_u32_b32 %0, -1, 0\n\tv_mbcnt_hi_u32_b32 %0, -1, %0" : "=&v"(tid_)); tid_ += wave0 * 64; const int tid = tid_, lane = tid & 63, wave = __builtin_amdgcn_readfirstlane(tid >> 6), gw = bx * 8 + wave; (void)lane; (void)gw
#define WS_SETUP() unsigned char* ws = P.ws; asm volatile("" : "+s"(ws)); \
    float* cosT = (float*)(ws + WS_COS); float* sinT = (float*)(ws + WS_SIN); float* bias1 = (float*)(ws + WS_BIAS1); float* LSE = (float*)(ws + WS_LSE); \
    bf16_t* HID = (bf16_t*)(ws + WS_HID); bf16_t* KVC = (bf16_t*)(ws + WS_KVC); bf16_t* XN = (bf16_t*)(ws + WS_XN); bf16_t* MIX = XN; bf16_t* Z = (bf16_t*)(ws + WS_Z); bf16_t* H = Z; float* X = P.out; bf16_t* XB = (bf16_t*)(ws + WS_XB); float* SS = (float*)(ws + WS_SS); (void)XB; (void)SS; \
    (void)cosT; (void)sinT; (void)bias1; (void)LSE; (void)HID; (void)KVC; (void)XN; (void)MIX; (void)Z; (void)H; (void)X
    unsigned gt = 0;
    unsigned* barw = (unsigned*)(P.ws + WS_BAR);
    volatile LAS unsigned* barst = (volatile LAS unsigned*)(lds + LDS_BARST);
    { TID_SETUP();
    if (tid == 0) { barst[0] = 0u; barst[1] = 0u; }
    if (bx == 0) { for (int i = tid; i < XCD_BAR_WORDS; i += 512) __hip_atomic_store(barw + i, 0u, __ATOMIC_RELAXED, __HIP_MEMORY_SCOPE_AGENT); } }
    __syncthreads();

    {
        TID_SETUP(); WS_SETUP();
        LAS float* scr = (LAS float*)(lds + wave * 8704);
        constexpr int I0 = 16 * 72, I1 = 16 * 32, I2 = 16 * 96, I3 = 16 * 32, I4 = 16 * 176, I6 = 44 * 32, I8 = 32 * 8, I10 = 4 * 8;
        constexpr int NIT = I0 + I1 + I2 + I3 + 2 * I4 + 2 * I6 + 2 * I8 + 2 * I10;
        for (int it = gw; it < NIT; it += NGW) {
            int r = it;
            if (r < I0) { tr_item(P.in[4], 1024, 2072, P.in[1], (bf16_t*)(ws + W_IN), 0, 72, scr, r, lane); continue; } r -= I0;
            if (r < I1) { tr_item(P.in[5], 1024, 1024, nullptr, (bf16_t*)(ws + W_OUTE), 1, 32, scr, r, lane); continue; } r -= I1;
            if (r < I2) { tr_item(P.in[13], 1024, 3072, P.in[1] + 1024, (bf16_t*)(ws + W_QKV), 2, 96, scr, r, lane); continue; } r -= I2;
            if (r < I3) { tr_item(P.in[14], 1024, 1024, nullptr, (bf16_t*)(ws + W_OUTO), 1, 32, scr, r, lane); continue; } r -= I3;
            if (r < I4) { tr_item(P.in[15], 1024, 5632, P.in[2], (bf16_t*)(ws + W_GU0), 3, 176, scr, r, lane); continue; } r -= I4;
            if (r < I4) { tr_item(P.in[15] + (size_t)1024 * 5632, 1024, 5632, P.in[2] + 1024, (bf16_t*)(ws + W_GU1), 3, 176, scr, r, lane); continue; } r -= I4;
            if (r < I6) { tr_item(P.in[16], 2816, 1024, nullptr, (bf16_t*)(ws + W_DN0), 1, 32, scr, r, lane); continue; } r -= I6;
            if (r < I6) { tr_item(P.in[16] + (size_t)2816 * 1024, 2816, 1024, nullptr, (bf16_t*)(ws + W_DN1), 1, 32, scr, r, lane); continue; } r -= I6;
            if (r < I8) { tr_item(P.in[8], 2048, 256, nullptr, (bf16_t*)(ws + W_W1), 1, 8, scr, r, lane); continue; } r -= I8;
            if (r < I8) { tr_item(P.in[10], 2048, 256, nullptr, (bf16_t*)(ws + W_W1) + (size_t)256 * 2048, 1, 8, scr, r, lane); continue; } r -= I8;
            if (r < I10) { tr_item(P.in[9], 256, 64, nullptr, (bf16_t*)(ws + W_W2), 4, 8, scr, r, lane); continue; } r -= I10;
            tr_item(P.in[11], 256, 64, nullptr, (bf16_t*)(ws + W_W2) + (size_t)256 * 256, 5, 8, scr, r, lane);
        }
        for (int e = bx * 512 + tid; e < T * 32; e += G * 512) { const int t = e >> 5, i = e & 31; float c, s; sincos_d((float)t * P.inv_freq[i], c, s); cosT[e] = c; sinT[e] = s; }
        if (bx >= G - 32) {
            const int c = G - 1 - bx, j = tid; const float* pe = j < 256 ? P.in[6] : P.in[7]; const float* w1 = j < 256 ? P.in[8] : P.in[10];
            float s = 0.f;
#pragma unroll 16
            for (int kk = c * 64; kk < c * 64 + 64; ++kk) s += *(const GAS float*)(pe + kk) * *(const GAS float*)(w1 + (size_t)kk * 256 + (j & 255));
            *(GAS float*)(bias1 + 512 + c * 512 + j) = s;
        }
        for (int mrow = gw; mrow < M; mrow += NGW) row_to_bf16_ss(P.in[0] + (size_t)mrow * D, XB + (size_t)mrow * D, SS + (size_t)mrow * 16, lane);
    }
    grid.sync();
    const XcdBarrier xbar = xcd_barrier_post(barw, barst, wave0);
#define GRID_BAR() do { XcdBarrier t_ = xbar; asm volatile("" : "+s"(t_.x), "+s"(t_.bar)); xcd_barrier(t_); } while (0)
    {   WS_SETUP();
        if (bx == 0) { TID_SETUP(); float s = 0.f;
#pragma unroll 8
            for (int c = 0; c < 32; ++c) s += *(const GAS float*)(bias1 + 512 + c * 512 + tid);
            *(GAS float*)(bias1 + tid) = s; }
        pg8::Gemm g{XB, (const bf16_t*)(ws + W_IN), M, 2304, 1024, 1024, 128, 0, (long)256 * 1024 * 2, 0, 0};
        pg8::StaticOrder S; S.init(M, 2304, G, bx);
        const unsigned rope = 0xFu | (1u << 6) | (1u << 8) | (0xFu << 10) | (1u << 14), dual = 0xFu, scal = 0xFu | (0xFu << 10);
        EpiZ<0> E{Z, ZP0, rope, dual, scal, C_AQR, cosT, sinT, SS};
        pg8::gemm_phase<EpiZ<0>, pg8::StaticOrder, true, true>(lds, g, S, E, wave0);
    }
    GRID_BAR();
    {   WS_SETUP();
        pg8::Gemm g{Z, (const bf16_t*)(ws + W_W1), 32 * 256, 512, 2048, 16 * ZP0, ZP0 * 2, 1, (long)T * ZP0 * 2, 64 * 2, 128 * 2};
        g.A = Z + C_AKC;
        pg8::StaticOrder S; S.init(32 * 256, 512, G, bx);
        EpiB<1> E{HID, 512, bias1};
        pg8::gemm_phase<EpiB<1>, pg8::StaticOrder, true, true>(lds, g, S, E, wave0);
        asm volatile("s_waitcnt vmcnt(0)" ::: "memory");
        __builtin_amdgcn_fence(__ATOMIC_RELEASE, "agent"); __syncthreads(); __builtin_amdgcn_fence(__ATOMIC_ACQUIRE, "agent");
        {
            pg8::Gemm g2{HID, (const bf16_t*)(ws + W_W2), 32 * 256, 512, 256, 512, 128, 0, (long)256 * 512 * 2, 0, 256 * 2};
            EpiB<0> E2{KVC, 512, nullptr};
            pg8::gemm_phase<EpiB<0>, pg8::StaticOrder, true, true>(lds, g2, S, E2, wave0);
        }
        __syncthreads();
        if (G > 64) {
            if (bx < 64) { for (int j = 0; j < 2; ++j) { const int u = bx * 2 + j, qb = u & 63, bh = u >> 6; b_unit(Z, MIX, P.in[12], lds, bh >> 1, bh & 1, qb, gt, wave0); } }
            else { for (int u = 128 + (bx - 64); u < 2048; u += G - 64) { const int qb = u & 63, bh = u >> 6; b_unit(Z, MIX, P.in[12], lds, bh >> 1, bh & 1, qb, gt, wave0); } }
        } else { for (int u = bx; u < 2048; u += G) { const int qb = u & 63, bh = u >> 6; b_unit(Z, MIX, P.in[12], lds, bh >> 1, bh & 1, qb, gt, wave0); } }
        __syncthreads();
    }
    GRID_BAR();
    {   WS_SETUP();
        for (int i = 0; i * G + bx < 2048; ++i) { const int u = i * G + bx, j = u >> 5, lvl = j & 7, rnd = j >> 3; const int qb = 63 - (8 * rnd + ((rnd & 1) ? 7 - lvl : lvl)); const int bh = u & 31;
            nsa_unit(Z, KVC, MIX, lds, bh >> 1, bh & 1, qb, gt, wave0); }
        __syncthreads();
    }
    GRID_BAR();
    {   WS_SETUP();
        pg8::Gemm g{MIX, (const bf16_t*)(ws + W_OUTE), M, 1024, 1024, 1024, 128, 0, (long)256 * 1024 * 2, 0, 0};
        pg8::StaticOrder S; S.init(M, 1024, G, bx);
        EpiRes<false> E{nullptr, XB, SS, 1024};
        pg8::gemm_phase<EpiRes<false>, pg8::StaticOrder, true, true>(lds, g, S, E, wave0);
    }
    GRID_BAR();
    for (int layer = 0; layer < 2; ++layer) {
        if (layer == 1) {
            {   WS_SETUP();
                pg8::Gemm g{XB, (const bf16_t*)(ws + W_QKV), M, 3072, 1024, 1024, 128, 0, (long)256 * 1024 * 2, 0, 0};
                pg8::StaticOrder S; S.init(M, 3072, G, bx);
                EpiZ<1> E{Z, ZP1, 0xFFFFu, 0u, 0xFFu, 0, cosT, sinT, SS};
                pg8::gemm_phase<EpiZ<1>, pg8::StaticOrder, true, true>(lds, g, S, E, wave0);
            }
            GRID_BAR();
            for (int pi = 0; pi < 3; ++pi) {
                WS_SETUP();
                c_phase(Z, MIX, LSE, lds, pi, bx, G, gt, wave0, 4096);
                __syncthreads();
                GRID_BAR();
            }
            {   WS_SETUP();
                pg8::Gemm g{MIX, (const bf16_t*)(ws + W_OUTO), M, 1024, 1024, 1024, 128, 0, (long)256 * 1024 * 2, 0, 0};
                pg8::StaticOrder S; S.init(M, 1024, G, bx);
                EpiRes<false> E{nullptr, XB, SS, 1024};
                pg8::gemm_phase<EpiRes<false>, pg8::StaticOrder, true, true>(lds, g, S, E, wave0);
            }
            GRID_BAR();
        }
        {   WS_SETUP();
            pg8::Gemm g{XB, (const bf16_t*)(ws + (layer == 0 ? W_GU0 : W_GU1)), M, 5632, 1024, 1024, 128, 0, (long)256 * 1024 * 2, 0, 0};
            pg8::StaticOrder S; S.init(M, 5632, G, bx);
            EpiSwiglu E{H, FF, SS};
            pg8::gemm_phase<EpiSwiglu, pg8::StaticOrder, true, true>(lds, g, S, E, wave0);
        }
        GRID_BAR();
        {   WS_SETUP();
            pg8::Gemm g{H, (const bf16_t*)(ws + (layer == 0 ? W_DN0 : W_DN1)), M, 1024, FF, FF, 128, 0, (long)256 * FF * 2, 0, 0};
            pg8::StaticOrder S; S.init(M, 1024, G, bx, 1);
            EpiRes<false> E{nullptr, XB, SS, 1024};
            pg8::gemm_phase<EpiRes<false>, pg8::StaticOrder, true, true>(lds, g, S, E, wave0);
        }
        GRID_BAR();
    }
    { TID_SETUP(); WS_SETUP();
    for (int mrow = gw; mrow < M; mrow += NGW) rms_row_final(XB + (size_t)mrow * D, X + (size_t)mrow * D, P.in[3], SS + (size_t)mrow * 16, lane); }
}

extern "C" void kernel_launch(void* const* d_in, const int* in_sizes, int n_in, void* d_out, int out_size, void* d_ws, size_t ws_size, hipStream_t stream) {
    static int grid = 0;
    if (grid == 0) {
        if (n_in != 17 || out_size != M * D || ws_size < WS_END) { fprintf(stderr, "kernel_launch: unexpected problem shape (n_in %d out %d ws %zu)\n", n_in, out_size, ws_size); grid = -1; return; }
        int dev = 0, cus = 0, per_cu = 0;
        hipGetDevice(&dev); hipDeviceGetAttribute(&cus, hipDeviceAttributeMultiprocessorCount, dev);
        hipFuncSetAttribute((const void*)fwd_mega, hipFuncAttributeMaxDynamicSharedMemorySize, LDS_BYTES);
        hipOccupancyMaxActiveBlocksPerMultiprocessor(&per_cu, (const void*)fwd_mega, 512, LDS_BYTES);
        if (per_cu < 1) { fprintf(stderr, "kernel_launch: occupancy query says %d blocks per CU\n", per_cu); per_cu = 1; }
        (void)hipGetLastError();
        grid = cus * 1;
    }
    if (grid < 0) return;
    Params p{};
    for (int i = 0; i < 17; ++i) p.in[i] = (const float*)d_in[i];
    p.out = (float*)d_out; p.ws = (unsigned char*)d_ws;
    for (int i = 0; i < 32; ++i) p.inv_freq[i] = 1.0f / powf(10000.0f, (float)(2 * i) / 64.0f);
    void* args[] = {&p};
    hipError_t e = hipLaunchCooperativeKernel((const void*)fwd_mega, dim3(grid), dim3(512), args, LDS_BYTES, stream);
    if (e != hipSuccess) fprintf(stderr, "cooperative launch failed: %s (grid %d)\n", hipGetErrorString(e), grid);
}
```

```cpp
#include <hip/hip_runtime.h>
#include <hip/hip_cooperative_groups.h>
#include <hip/hip_bf16.h>
#include <cstdio>
#include <cstdint>
namespace cg = cooperative_groups;
namespace pg8 {
#define PG8_LAS __attribute__((address_space(3)))
typedef unsigned short bf16_t;
typedef short bf16x8 __attribute__((ext_vector_type(8)));
typedef float f32x4 __attribute__((ext_vector_type(4)));
typedef unsigned u32x4 __attribute__((ext_vector_type(4)));
struct Unit { int pm, pn; };
constexpr int BM = 256, BK = 64, HALF = 128, HTB = HALF * BK * 2  , STAGE_BYTES = 8 * HTB, NXCD = 8, WGM = 4;

__host__ __device__ __forceinline__ int lds_byte(int r, int c) { const int st = (r >> 4) * 2 + (c >> 5), rr = r & 15, cc = c & 31, ob = rr * 64 + cc * 2; return st * 1024 + (ob ^ (((ob >> 9) & 1) << 5)); }
__host__ __device__ __forceinline__ void stage_rc(int b, int& R, int& C) { const int st = b / 1024, sb = b % 1024, swz = sb ^ (((sb >> 9) & 1) << 5); R = (st >> 1) * 16 + swz / 64; C = (st & 1) * 32 + (swz % 64) / 2; }
__host__ __device__ __forceinline__ int perm32(int rho) { const int n = rho >> 4, i = rho & 15; return 8 * (i >> 2) + 4 * n + (i & 3); }

struct Gemm { const bf16_t* A; const bf16_t* Bt; int M, N, K; int lda; int kstepA; int sh; long s1, s0, sp; };
__device__ __forceinline__ const char* a_base(const Gemm& g, const struct Unit& u);

struct StaticOrder {
    int nM, nN, nwg, G, c, rev;
    __host__ __device__ void init(int M, int N, int G_, int c_, int rev_ = 0) { nM = M / BM; nN = N / BM; nwg = nM * nN; G = G_; c = c_; rev = rev_; }
    __host__ __device__ bool next(int i, Unit& u) const {
        const long L = (long)i * G + c; if (L >= nwg) return false;
        int wgid = (int)L; { const int q = nwg / NXCD, r = nwg % NXCD, xcd = wgid % NXCD, off = wgid / NXCD; wgid = (xcd < r ? xcd * (q + 1) : r * (q + 1) + (xcd - r) * q) + off; }
        const int nig = WGM * nN, gid = wgid / nig, fm = gid * WGM, gsz = (nM - fm) < WGM ? (nM - fm) : WGM;
        u.pm = fm + ((wgid % nig) % gsz); u.pn = (wgid % nig) / gsz; if (rev) u.pm = nM - 1 - u.pm; return true;
    }
    __device__ __forceinline__ void a_ready(const Unit&) const {}
    __device__ __forceinline__ void done(const Unit&) const {}
};


__device__ __forceinline__ const char* a_base(const Gemm& g, const Unit& u) { return (const char*)g.A + (size_t)(u.pm >> g.sh) * g.s1 + (size_t)(u.pm & ((1 << g.sh) - 1)) * g.s0 + (size_t)u.pn * g.sp; }
template <class Epi, class Sched, bool ALIGN_EPI = false, bool SP2 = false>
__device__ __forceinline__ void gemm_phase(PG8_LAS unsigned char* lds, const Gemm g, const Sched& S, const Epi& E, int wave0) {
    int tid_; asm volatile("v_mbcnt_lo_u32_b32 %0, -1, 0\n\tv_mbcnt_hi_u32_b32 %0, -1, %0" : "=&v"(tid_)); tid_ += wave0 * 64; const int tid = tid_, wid = __builtin_amdgcn_readfirstlane(tid >> 6), lane = tid & 63, wr = wid >> 2, wc = wid & 3, fr = lane & 15, fq = lane >> 4;
    const int K = g.K, nt = K / BK;
    unsigned voffA[2], voffB[2];
#pragma unroll
    for (int i = 0; i < 2; ++i) { int R, C; stage_rc(tid * 16 + i * 8192, R, C); const int Rb = Epi::PERM ? ((R & ~31) + perm32(R & 31)) : R;
        voffA[i] = (unsigned)(R * g.lda + C) * 2u; voffB[i] = (unsigned)(Rb * K + C) * 2u; }
    const size_t kstep = (size_t)(BK * 2); const size_t kstepA = (size_t)g.kstepA; const size_t hstepA = (size_t)HALF * g.lda * 2;
    const size_t hstep = (size_t)HALF * K * 2;
    const size_t tstep = 2 * hstep;
    const unsigned ldsw = (unsigned)wid * 1024u;
    const int aoff = lds_byte(wr * 64 + fr, fq * 8), boff = lds_byte(wc * 32 + fr, fq * 8);
#define PG8_SA(b, h) (((b) * 2 + (h)) * HTB)
#define PG8_SB(b, h) ((4 + (b) * 2 + (h)) * HTB)
#define PG8_STAGE(bufoff, gbase, voff) do { _Pragma("unroll") for (int _i = 0; _i < 2; ++_i) \
        __builtin_amdgcn_global_load_lds((const unsigned*)((const char*)(gbase) + (voff)[_i]), (PG8_LAS unsigned*)(lds + (bufoff) + ldsw + _i * 8192), 16, 0, 0); } while (0)
#define PG8_LDA(dst, b, h) do { _Pragma("unroll") for (int m = 0; m < 4; ++m) _Pragma("unroll") for (int k = 0; k < 2; ++k) dst[m][k] = *(const PG8_LAS bf16x8*)(lds + PG8_SA(b, h) + aoff + m * 2048 + k * 1024); } while (0)
#define PG8_LDB(dst, b, h) do { _Pragma("unroll") for (int n = 0; n < 2; ++n) _Pragma("unroll") for (int k = 0; k < 2; ++k) dst[n][k] = *(const PG8_LAS bf16x8*)(lds + PG8_SB(b, h) + boff + n * 2048 + k * 1024); } while (0)
#define PG8_MMA(ai, bj, At, Bt) do { __builtin_amdgcn_s_setprio(1); _Pragma("unroll") for (int m = 0; m < 4; ++m) _Pragma("unroll") for (int n = 0; n < 2; ++n) _Pragma("unroll") for (int k = 0; k < 2; ++k) \
        acc[ai][bj][m][n] = __builtin_amdgcn_mfma_f32_16x16x32_bf16(Bt[n][k], At[m][k], acc[ai][bj][m][n], 0, 0, 0); __builtin_amdgcn_s_setprio(0); } while (0)
#define PG8_WAIT_V(n) asm volatile("s_waitcnt vmcnt(" #n ")" ::: "memory")
#define PG8_WAIT_L(n) asm volatile("s_waitcnt lgkmcnt(" #n ")" ::: "memory")
#define PG8_BAR __builtin_amdgcn_s_barrier()
#define PG8_SCHED __builtin_amdgcn_sched_barrier(0)
    Unit cur, nxt; int ui = 0;
    if (!S.next(0, cur)) return;
    f32x4 acc[2][2][4][2];
#pragma unroll
    for (int a = 0; a < 2; ++a)
#pragma unroll
        for (int b = 0; b < 2; ++b)
#pragma unroll
            for (int m = 0; m < 4; ++m)
#pragma unroll
                for (int n = 0; n < 2; ++n) acc[a][b][m][n] = (f32x4){0.f, 0.f, 0.f, 0.f};
    bf16x8 At[4][2], B0[2][2], B1[2][2];
    const char* cA = a_base(g, cur); const char* cB = (const char*)g.Bt + (size_t)cur.pn * tstep;
    S.a_ready(cur);
    if constexpr (SP2) {
        PG8_STAGE(PG8_SB(0, 0), cB, voffB); PG8_STAGE(PG8_SB(0, 1), cB + hstep, voffB); PG8_STAGE(PG8_SA(0, 0), cA, voffA); PG8_STAGE(PG8_SA(0, 1), cA + hstepA, voffA);
        if (wr == 1) PG8_BAR;
        PG8_WAIT_V(2); PG8_BAR;
        PG8_STAGE(PG8_SB(1, 0), cB + kstep, voffB); PG8_STAGE(PG8_SA(1, 0), cA + kstepA, voffA); PG8_STAGE(PG8_SB(1, 1), cB + hstep + kstep, voffB);
        PG8_WAIT_V(6); PG8_BAR;
    } else {
        PG8_STAGE(PG8_SB(0, 0), cB, voffB); PG8_STAGE(PG8_SA(0, 0), cA, voffA); PG8_STAGE(PG8_SB(0, 1), cB + hstep, voffB); PG8_STAGE(PG8_SA(0, 1), cA + hstepA, voffA);
        if (wr == 1) PG8_BAR;
        PG8_WAIT_V(4); PG8_BAR;
        PG8_STAGE(PG8_SB(1, 0), cB + kstep, voffB); PG8_STAGE(PG8_SA(1, 0), cA + kstepA, voffA); PG8_STAGE(PG8_SB(1, 1), cB + hstep + kstep, voffB);
        PG8_WAIT_V(6); PG8_BAR;
    }
    for (;;) {
        const bool has_next = S.next(ui + 1, nxt);
        const char* nA = has_next ? a_base(g, nxt) : cA; const char* nB = has_next ? (const char*)g.Bt + (size_t)nxt.pn * tstep : cB;
        for (int t = 0; t < nt; t += 2) {
            const bool last = (t == nt - 2);
            const char* a1 = cA + (size_t)(t + 1) * kstepA;
            const char* a2 = last ? nA : cA + (size_t)(t + 2) * kstepA; const char* b2 = last ? nB : cB + (size_t)(t + 2) * kstep;
            const char* a3 = a2 + kstepA; const char* b3 = b2 + kstep;
            if (last && has_next) S.a_ready(nxt);
            if constexpr (SP2) {
            PG8_LDB(B0, 0, 0); PG8_LDB(B1, 0, 1); PG8_SCHED; PG8_LDA(At, 0, 0); PG8_STAGE(PG8_SA(1, 1), a1 + hstepA, voffA);
            PG8_WAIT_V(8); PG8_WAIT_L(0); PG8_BAR; PG8_MMA(0, 0, At, B0); PG8_MMA(0, 1, At, B1); PG8_BAR; PG8_SCHED;
            PG8_LDA(At, 0, 1); PG8_STAGE(PG8_SB(0, 0), b2, voffB); PG8_STAGE(PG8_SB(0, 1), b2 + hstep, voffB); PG8_STAGE(PG8_SA(0, 0), a2, voffA);
            PG8_WAIT_V(8); PG8_WAIT_L(0); PG8_BAR; PG8_MMA(1, 0, At, B0); PG8_MMA(1, 1, At, B1); PG8_BAR; PG8_SCHED;
            PG8_LDB(B0, 1, 0); PG8_LDB(B1, 1, 1); PG8_SCHED; PG8_LDA(At, 1, 0); PG8_STAGE(PG8_SA(0, 1), a2 + hstepA, voffA);
            PG8_WAIT_V(8); PG8_WAIT_L(0); PG8_BAR; PG8_MMA(0, 0, At, B0); PG8_MMA(0, 1, At, B1); PG8_BAR; PG8_SCHED;
            PG8_LDA(At, 1, 1); PG8_STAGE(PG8_SB(1, 0), b3, voffB); PG8_STAGE(PG8_SB(1, 1), b3 + hstep, voffB); PG8_STAGE(PG8_SA(1, 0), a3, voffA);
            PG8_WAIT_V(8); PG8_WAIT_L(0); PG8_BAR; PG8_MMA(1, 0, At, B0); PG8_MMA(1, 1, At, B1); PG8_BAR; PG8_SCHED;
            } else {
            PG8_LDB(B0, 0, 0); PG8_SCHED; PG8_LDA(At, 0, 0); PG8_STAGE(PG8_SA(1, 1), a1 + hstepA, voffA);
            PG8_WAIT_L(8); PG8_BAR; PG8_WAIT_L(0); PG8_MMA(0, 0, At, B0); PG8_BAR; PG8_SCHED;
            PG8_LDB(B1, 0, 1); PG8_STAGE(PG8_SB(0, 0), b2, voffB);
            PG8_BAR; PG8_WAIT_L(0); PG8_MMA(0, 1, At, B1); PG8_BAR;
            PG8_LDA(At, 0, 1); PG8_STAGE(PG8_SA(0, 0), a2, voffA);
            PG8_BAR; PG8_WAIT_L(0); PG8_MMA(1, 0, At, B0); PG8_BAR; PG8_SCHED;
            PG8_STAGE(PG8_SB(0, 1), b2 + hstep, voffB);
            PG8_WAIT_V(6); PG8_BAR; PG8_MMA(1, 1, At, B1); PG8_BAR;
            PG8_LDB(B0, 1, 0); PG8_SCHED; PG8_LDA(At, 1, 0); PG8_STAGE(PG8_SA(0, 1), a2 + hstepA, voffA);
            PG8_WAIT_L(8); PG8_BAR; PG8_WAIT_L(0); PG8_MMA(0, 0, At, B0); PG8_BAR; PG8_SCHED;
            PG8_LDB(B1, 1, 1); PG8_STAGE(PG8_SB(1, 0), b3, voffB);
            PG8_BAR; PG8_WAIT_L(0); PG8_MMA(0, 1, At, B1); PG8_BAR;
            PG8_LDA(At, 1, 1); PG8_STAGE(PG8_SA(1, 0), a3, voffA);
            PG8_BAR; PG8_WAIT_L(0); PG8_MMA(1, 0, At, B0); PG8_BAR; PG8_SCHED;
            PG8_STAGE(PG8_SB(1, 1), b3 + hstep, voffB);
            PG8_WAIT_V(6); PG8_BAR; PG8_MMA(1, 1, At, B1); PG8_BAR;
            }
        }
        if constexpr (ALIGN_EPI) { if (wr == 0) PG8_BAR; }
        if constexpr (!Epi::AFTER_DRAIN) { E(acc, cur, wr, wc, fr, fq); S.done(cur); }
        if (!has_next) break;
#pragma unroll
        for (int a = 0; a < 2; ++a)
#pragma unroll
            for (int b = 0; b < 2; ++b)
#pragma unroll
                for (int m = 0; m < 4; ++m)
#pragma unroll
                    for (int n = 0; n < 2; ++n) acc[a][b][m][n] = (f32x4){0.f, 0.f, 0.f, 0.f};
        cur = nxt; cA = nA; cB = nB; ++ui;
        if constexpr (ALIGN_EPI) { if (wr == 1) PG8_BAR; }
    }
    PG8_WAIT_V(0);
    if constexpr (!ALIGN_EPI) { if (wr == 0) PG8_BAR; }
    PG8_BAR;
    if constexpr (Epi::AFTER_DRAIN) { E.fused(acc, cur, wr, wc, fr, fq, lds, wid, lane); S.done(cur); }
#undef PG8_SA
#undef PG8_SB
#undef PG8_STAGE
#undef PG8_LDA
#undef PG8_LDB
#undef PG8_MMA
#undef PG8_WAIT_V
#undef PG8_WAIT_L
#undef PG8_BAR
#undef PG8_SCHED
}
}

using pg8::bf16_t; using pg8::bf16x8; using pg8::f32x4; using pg8::u32x4; using pg8::Unit;
#define LAS __attribute__((address_space(3)))
#define GAS_ __attribute__((address_space(1)))
typedef LAS unsigned char* ldsp;
typedef float f32x16 __attribute__((ext_vector_type(16)));
typedef short s16x4 __attribute__((ext_vector_type(4)));
typedef float f32x2_t __attribute__((ext_vector_type(2)));
typedef __bf16 bf16x2_t __attribute__((ext_vector_type(2)));
typedef unsigned u32x2 __attribute__((ext_vector_type(2)));

constexpr int NB = 16, T = 4096, D = 1024, M = NB * T, FF = 2816;
constexpr int ZP0 = 2816, ZP1 = 3072;
constexpr int C_AQP = 0, C_AKC = 512, C_AVC = 640, C_AKS = 768, C_AVS = 896, C_AKW = 1024, C_AVW = 1152, C_BQ = 1280, C_BK = 1792, C_BV = 1920, C_GATE = 2048, C_AQR = 2304;
constexpr float LOG2E = 1.4426950408889634f;
constexpr float C2 = 0.125f * LOG2E;
constexpr float NORM_EPS = 1e-5f;
constexpr float NEG_INF = -__builtin_huge_valf();

constexpr size_t MiB = 1u << 20;
constexpr size_t WS_BAR = 1536 * 1024;
constexpr size_t WS_COS = 0, WS_SIN = 512 * 1024, WS_BIAS1 = 1 * MiB, WS_LSE = 2 * MiB, WS_HID = 6 * MiB, WS_KVC = 14 * MiB;
constexpr size_t W_IN = 22 * MiB, W_OUTE = W_IN + 2304ull * 1024 * 2, W_QKV = W_OUTE + 2 * MiB, W_OUTO = W_QKV + 6 * MiB, W_GU0 = W_OUTO + 2 * MiB, W_GU1 = W_GU0 + 11 * MiB,
                 W_DN0 = W_GU1 + 11 * MiB, W_DN1 = W_DN0 + 5632ull * 1024, W_W1 = W_DN1 + 5632ull * 1024, W_W2 = W_W1 + 2 * MiB, W_END = W_W2 + 256 * 1024;
static_assert(W_END <= 72 * MiB, "weights");
constexpr size_t WS_XN = 72 * MiB;
constexpr size_t WS_Z = 200 * MiB;
constexpr size_t WS_XB = 592 * MiB;
constexpr size_t WS_SS = 720 * MiB;
constexpr size_t WS_END = 724 * MiB;

constexpr int LDS_BYTES = 147456;
constexpr int LDS_WSF = 143360;
constexpr int LDS_BARST = 145472;
constexpr int LDS_NSA_RING = 65536, LDS_NSA_IMP = 98304, NSA_IMP_STRIDE = 4352;

struct Params { const float* in[17]; float* out; unsigned char* ws; float inv_freq[32]; };

#define LDS_WAIT() asm volatile("s_waitcnt lgkmcnt(0)" ::: "memory")
__device__ __forceinline__ unsigned f2bf(float f) { unsigned u = __builtin_bit_cast(unsigned, f); return (u + 0x7fffu + ((u >> 16) & 1u)) >> 16; }
__device__ __forceinline__ unsigned pk2(float lo, float hi) { f32x2_t v = {lo, hi}; bf16x2_t b = __builtin_convertvector(v, bf16x2_t); return __builtin_bit_cast(unsigned, b); }
__device__ __forceinline__ float bf2f(bf16_t v) { return __builtin_bit_cast(float, (unsigned)v << 16); }
__device__ __forceinline__ float wave_sum(float v) {
#pragma unroll
    for (int o = 1; o < 64; o <<= 1) v += __shfl_xor(v, o);
    return v;
}
__device__ __forceinline__ float fexp2(float x) { return __builtin_amdgcn_exp2f(x); }
__device__ __forceinline__ float silu_f(float g) { return g * __builtin_amdgcn_rcpf(1.0f + __expf(-g)); }
__device__ __forceinline__ float sigmoid_f(float g) { return __builtin_amdgcn_rcpf(1.0f + __expf(-g)); }


__device__ __forceinline__ void rows_rstd(float (&rs)[2][4], const float* SS, int row0, int fq) {
    f32x4 q[2][4];
#pragma unroll
    for (int ai = 0; ai < 2; ++ai)
#pragma unroll
        for (int m = 0; m < 4; ++m) q[ai][m] = *(const GAS_ f32x4*)(SS + (size_t)(row0 + ai * 128 + m * 16) * 16 + fq * 4);
#pragma unroll
    for (int ai = 0; ai < 2; ++ai)
#pragma unroll
        for (int m = 0; m < 4; ++m) { float s = (q[ai][m][0] + q[ai][m][1]) + (q[ai][m][2] + q[ai][m][3]); s += __shfl_xor(s, 16); s += __shfl_xor(s, 32);
            rs[ai][m] = 1.0f / sqrtf(s * (1.0f / 1024.0f) + 1e-5f); }
}
template <int HM> struct EpiZ {
    static constexpr bool PERM = true, AFTER_DRAIN = false;
    bf16_t* Z; int ldz; unsigned ropeMask, dualMask, scaleMask; int dualOff; const float* cosT; const float* sinT; const float* SS;
    __device__ __forceinline__ void operator()(const f32x4 (&acc)[2][2][4][2], const Unit& u, int wr, int wc, int fr, int fq) const {
        const int row0 = u.pm * 256 + wr * 64 + fr, col0 = u.pn * 256 + wc * 32 + 8 * fq, j0 = 16 * (wc & 1) + 4 * fq;
        float rsv[2][4];
        if (SS) rows_rstd(rsv, SS, row0, fq);
        const bool anyrope = ((ropeMask >> (2 * u.pn)) & 3u) != 0u;
#pragma unroll
        for (int ai = 0; ai < 2; ++ai) {
            f32x4 cc[4], ss[4];
            if (anyrope) {
#pragma unroll
                for (int m = 0; m < 4; ++m) { const int t = (row0 + ai * 128 + m * 16) & (T - 1); cc[m] = *(const GAS_ f32x4*)(cosT + t * 32 + j0); ss[m] = *(const GAS_ f32x4*)(sinT + t * 32 + j0); }
            }
            asm volatile("" ::: "memory");
#pragma unroll
            for (int m = 0; m < 4; ++m) {
                const int row = row0 + ai * 128 + m * 16;
                const f32x4 c4 = cc[m], s4 = ss[m];
                bf16_t* rowp = HM ? Z + ((size_t)(((row >> 12) * 3 + (col0 >> 10)) * 16 + ((col0 & 1023) >> 6)) * T + (row & (T - 1))) * 64 + (col0 & 63) : Z + (size_t)row * ldz + col0;
                constexpr int bjstep = HM ? 2 * T * 64 : 128;
                const float rs = SS ? rsv[ai][m] : 1.0f;
#pragma unroll
                for (int bj = 0; bj < 2; ++bj) {
                    const int h = u.pn * 2 + bj;
                    if (HM == 0 && col0 + bj * 128 >= 2072) continue;
                    const float sc = ((scaleMask >> h) & 1u) ? rs * C2 : rs;
                    f32x4 v0 = acc[ai][bj][m][0] * sc, v1 = acc[ai][bj][m][1] * sc;
                    int off = bj * bjstep;
                    if ((dualMask >> h) & 1u) { u32x4 w; w.x = pk2(v0[0], v0[1]); w.y = pk2(v0[2], v0[3]); w.z = pk2(v1[0], v1[1]); w.w = pk2(v1[2], v1[3]); *(GAS_ u32x4*)(rowp + off) = w; off += dualOff; }
                    if ((ropeMask >> h) & 1u) {
                        f32x4 a, b2;
                        a[0] = v0[0] * c4[0] - v0[1] * s4[0]; a[1] = v0[1] * c4[0] + v0[0] * s4[0];
                        a[2] = v0[2] * c4[1] - v0[3] * s4[1]; a[3] = v0[3] * c4[1] + v0[2] * s4[1];
                        b2[0] = v1[0] * c4[2] - v1[1] * s4[2]; b2[1] = v1[1] * c4[2] + v1[0] * s4[2];
                        b2[2] = v1[2] * c4[3] - v1[3] * s4[3]; b2[3] = v1[3] * c4[3] + v1[2] * s4[3];
                        v0 = a; v1 = b2;
                    }
                    u32x4 w; w.x = pk2(v0[0], v0[1]); w.y = pk2(v0[2], v0[3]); w.z = pk2(v1[0], v1[1]); w.w = pk2(v1[2], v1[3]);
                    *(GAS_ u32x4*)(rowp + off) = w;
                }
                asm volatile("" ::: "memory");
            }
        }
    }
};
struct EpiSwiglu {
    static constexpr bool PERM = true, AFTER_DRAIN = false;
    bf16_t* H; int ldh; const float* SS;
    __device__ __forceinline__ void operator()(const f32x4 (&acc)[2][2][4][2], const Unit& u, int wr, int wc, int fr, int fq) const {
        const int row0 = u.pm * 256 + wr * 64 + fr, hc0 = u.pn * 128 + wc * 32 + 8 * fq;
        float rsv[2][4];
        rows_rstd(rsv, SS, row0, fq);
#pragma unroll
        for (int ai = 0; ai < 2; ++ai)
#pragma unroll
            for (int m = 0; m < 4; ++m) {
                bf16_t* rowp = H + (size_t)(row0 + ai * 128 + m * 16) * ldh + hc0;
                const float rs = rsv[ai][m];
                const f32x4 g0 = acc[ai][0][m][0] * rs, g1 = acc[ai][0][m][1] * rs, u0 = acc[ai][1][m][0] * rs, u1 = acc[ai][1][m][1] * rs;
                u32x4 w; w.x = pk2(silu_f(g0[0]) * u0[0], silu_f(g0[1]) * u0[1]); w.y = pk2(silu_f(g0[2]) * u0[2], silu_f(g0[3]) * u0[3]);
                w.z = pk2(silu_f(g1[0]) * u1[0], silu_f(g1[1]) * u1[1]); w.w = pk2(silu_f(g1[2]) * u1[2], silu_f(g1[3]) * u1[3]);
                *(GAS_ u32x4*)rowp = w;
                asm volatile("" ::: "memory");
            }
    }
};
template <bool BASE_F32> struct EpiRes {
    static constexpr bool PERM = true, AFTER_DRAIN = false;
    const float* basef; bf16_t* XB; float* SS; int ldc;
    __device__ __forceinline__ void operator()(const f32x4 (&acc)[2][2][4][2], const Unit& u, int wr, int wc, int fr, int fq) const {
        const int row0 = u.pm * 256 + wr * 64 + fr, col0 = u.pn * 256 + wc * 32 + 8 * fq;
#pragma unroll
        for (int ai = 0; ai < 2; ++ai) {
            f32x4 bs[4][2][2]; u32x4 bh[4][2];
#pragma unroll
            for (int m = 0; m < 4; ++m) { const size_t off = (size_t)(row0 + ai * 128 + m * 16) * ldc + col0;
#pragma unroll
                for (int bj = 0; bj < 2; ++bj) {
                    if (BASE_F32) { bs[m][bj][0] = *(const GAS_ f32x4*)(basef + off + bj * 128); bs[m][bj][1] = *(const GAS_ f32x4*)(basef + off + bj * 128 + 4); }
                    else bh[m][bj] = *(const GAS_ u32x4*)(XB + off + bj * 128); } }
            asm volatile("" ::: "memory");
#pragma unroll
            for (int m = 0; m < 4; ++m) {
                const size_t off = (size_t)(row0 + ai * 128 + m * 16) * ldc + col0;
                float ssq = 0.f;
#pragma unroll
                for (int bj = 0; bj < 2; ++bj) {
                    f32x4 b0, b1;
                    if (BASE_F32) { b0 = bs[m][bj][0]; b1 = bs[m][bj][1]; }
                    else { const u32x4 h = bh[m][bj];
                        b0 = (f32x4){__builtin_bit_cast(float, h.x << 16), __builtin_bit_cast(float, h.x & 0xffff0000u), __builtin_bit_cast(float, h.y << 16), __builtin_bit_cast(float, h.y & 0xffff0000u)};
                        b1 = (f32x4){__builtin_bit_cast(float, h.z << 16), __builtin_bit_cast(float, h.z & 0xffff0000u), __builtin_bit_cast(float, h.w << 16), __builtin_bit_cast(float, h.w & 0xffff0000u)}; }
                    const f32x4 v0 = b0 + acc[ai][bj][m][0], v1 = b1 + acc[ai][bj][m][1];
                    ssq += ((v0[0] * v0[0] + v0[1] * v0[1]) + (v0[2] * v0[2] + v0[3] * v0[3])) + ((v1[0] * v1[0] + v1[1] * v1[1]) + (v1[2] * v1[2] + v1[3] * v1[3]));
                    u32x4 w; w.x = pk2(v0[0], v0[1]); w.y = pk2(v0[2], v0[3]); w.z = pk2(v1[0], v1[1]); w.w = pk2(v1[2], v1[3]); *(GAS_ u32x4*)(XB + off + bj * 128) = w;
                }
                ssq += __shfl_xor(ssq, 16); ssq += __shfl_xor(ssq, 32);
                if (fq == 0) *(GAS_ float*)(SS + (size_t)(row0 + ai * 128 + m * 16) * 16 + u.pn * 4 + wc) = ssq;
            }
            asm volatile("" ::: "memory");
        }
    }
};
template <int ACT> struct EpiB {
    static constexpr bool PERM = true, AFTER_DRAIN = false;
    bf16_t* O; int ldc; const float* bias;
    __device__ __forceinline__ void operator()(const f32x4 (&acc)[2][2][4][2], const Unit& u, int wr, int wc, int fr, int fq) const {
        const int row0 = u.pm * 256 + wr * 64 + fr, col0 = u.pn * 256 + wc * 32 + 8 * fq;
#pragma unroll
        for (int ai = 0; ai < 2; ++ai)
#pragma unroll
            for (int m = 0; m < 4; ++m) {
                bf16_t* rowp = O + (size_t)(row0 + ai * 128 + m * 16) * ldc + col0;
#pragma unroll
                for (int bj = 0; bj < 2; ++bj) {
                    f32x4 v0 = acc[ai][bj][m][0], v1 = acc[ai][bj][m][1];
                    if (bias) { v0 = v0 + *(const GAS_ f32x4*)(bias + col0 + bj * 128); v1 = v1 + *(const GAS_ f32x4*)(bias + col0 + bj * 128 + 4); }
                    if (ACT == 1) {
#pragma unroll
                        for (int e = 0; e < 4; ++e) { v0[e] = silu_f(v0[e]); v1[e] = silu_f(v1[e]); } }
                    u32x4 w; w.x = pk2(v0[0], v0[1]); w.y = pk2(v0[2], v0[3]); w.z = pk2(v1[0], v1[1]); w.w = pk2(v1[2], v1[3]);
                    *(GAS_ u32x4*)(rowp + bj * 128) = w;
                }
                asm volatile("" ::: "memory");
            }
    }
};
__device__ __forceinline__ int crow(int r, int hi) { return (r & 3) + 8 * (r >> 2) + 4 * hi; }
__device__ __forceinline__ float xh_max(float v) { auto rr = __builtin_amdgcn_permlane32_swap(__float_as_uint(v), __float_as_uint(v), false, false); return fmaxf(__uint_as_float(rr[0]), __uint_as_float(rr[1])); }
__device__ __forceinline__ float xh_sum(float v) { auto rr = __builtin_amdgcn_permlane32_swap(__float_as_uint(v), __float_as_uint(v), false, false); return __uint_as_float(rr[0]) + __uint_as_float(rr[1]); }
#define GAS __attribute__((address_space(1)))
__device__ __forceinline__ u32x4 ldg16(const bf16_t* p) { return *(const GAS u32x4*)p; }
__device__ __forceinline__ void tile_store(ldsp buf, const u32x4& k, const u32x4& v, int key, int ch) {
    *(LAS u32x4*)(buf + ch * 1024 + ((key ^ (2 * ch)) << 4)) = k;
    *(LAS u32x4*)(buf + 8192 + (ch >> 2) * 4096 + (key >> 4) * 1024 + (key & 15) * 64 + (ch & 3) * 16) = v;
}
__device__ __forceinline__ void q_load(bf16x8 (&qr)[4], const bf16_t* qrow, int hi) {
#pragma unroll
    for (int d0 = 0; d0 < 4; ++d0) qr[d0] = *(const GAS bf16x8*)(qrow + d0 * 16 + hi * 8);
}
__device__ __forceinline__ float max3f(float a, float b, float c) { float r; asm("v_max3_f32 %0, %1, %2, %3" : "=v"(r) : "v"(a), "v"(b), "v"(c)); return r; }
__device__ __forceinline__ void qk_tile(f32x16& p0, f32x16& p1, const ldsp Kt, const bf16x8 (&qr)[4], const f32x16& cin, int r32, int hi) {
    const ldsp kb = Kt + hi * 1024; const int ks = (r32 ^ (2 * hi)) << 4;
    __builtin_amdgcn_s_setprio(1);
#pragma unroll
    for (int d0 = 0; d0 < 4; ++d0) {
        const ldsp kp = kb + d0 * 2048 + (ks ^ (64 * d0));
        const bf16x8 b0 = *(const LAS bf16x8*)(kp), b1 = *(const LAS bf16x8*)(kp + 512);
        if (d0 == 0) { p0 = __builtin_amdgcn_mfma_f32_32x32x16_bf16(b0, qr[0], cin, 0, 0, 0); p1 = __builtin_amdgcn_mfma_f32_32x32x16_bf16(b1, qr[0], cin, 0, 0, 0); }
        else { p0 = __builtin_amdgcn_mfma_f32_32x32x16_bf16(b0, qr[d0], p0, 0, 0, 0); p1 = __builtin_amdgcn_mfma_f32_32x32x16_bf16(b1, qr[d0], p1, 0, 0, 0); }
    }
    __builtin_amdgcn_s_setprio(0);
    asm volatile("s_nop 15\n\ts_nop 7" : "+v"(p0), "+v"(p1));
}
__device__ __forceinline__ void mask_tile(f32x16& p0, f32x16& p1, int lo, int hq, int hi) {
    const bool nl = __any(lo > 0), nh = __any(hq < 63);
    if (nh && nl) {
#pragma unroll
        for (int r = 0; r < 16; ++r) { const int kk = crow(r, hi);
            if (!(kk >= lo && kk <= hq)) p0[r] = NEG_INF;
            if (!(kk + 32 >= lo && kk + 32 <= hq)) p1[r] = NEG_INF; }
    } else if (nh) {
        const int h2 = hq - 4 * hi;
#pragma unroll
        for (int r = 0; r < 16; ++r) { const int kc = (r & 3) + 8 * (r >> 2);
            if (kc > h2) p0[r] = NEG_INF;
            if (kc + 32 > h2) p1[r] = NEG_INF; }
    } else if (nl) {
        const int l2 = lo - 4 * hi;
#pragma unroll
        for (int r = 0; r < 16; ++r) { const int kc = (r & 3) + 8 * (r >> 2);
            if (kc < l2) p0[r] = NEG_INF;
            if (kc + 32 < l2) p1[r] = NEG_INF; }
    }
}
__device__ __forceinline__ float tile_max(const f32x16& p0, const f32x16& p1) {
    float a = max3f(p0[0], p0[1], p1[0]), b = max3f(p0[2], p0[3], p1[1]); a = max3f(a, p1[2], p1[3]);
#pragma unroll
    for (int r = 4; r < 16; r += 4) { a = max3f(a, p0[r], p0[r + 1]); b = max3f(b, p0[r + 2], p0[r + 3]); a = max3f(a, p1[r], p1[r + 1]); b = max3f(b, p1[r + 2], p1[r + 3]); }
    return xh_max(max3f(a, b, b));
}
__device__ __forceinline__ void splat16(f32x16& v, float x) {
#pragma unroll
    for (int r = 0; r < 16; ++r) v[r] = x;
    asm volatile("" : "+v"(v));
}
constexpr float SM_THR = 6.0f;
__device__ __forceinline__ void sm_update(f32x16& p0, f32x16& p1, float& mref, f32x16& negm, float& l, f32x16 (&o)[2], bool first, LAS float* wsf, int r32, int hi) {
    const float rm = tile_max(p0, p1);
    if (first || __any(rm > SM_THR)) {
        const float dl = first ? ((rm == NEG_INF) ? 0.f : rm) : fmaxf(rm, 0.f);
        mref += dl;
#pragma unroll
        for (int r = 0; r < 16; ++r) { p0[r] -= dl; p1[r] -= dl; }
        splat16(negm, -mref);
        if (!first) {
            const float f = fexp2(-dl);
            l *= f;
            if (hi == 0) wsf[r32] = f;
            LDS_WAIT();
#pragma unroll
            for (int r = 0; r < 16; ++r) { const float g = wsf[crow(r, hi)]; o[0][r] *= g; o[1][r] *= g; }
            LDS_WAIT();
        }
    }
    float s = 0.f;
#pragma unroll
    for (int r = 0; r < 16; ++r) { p0[r] = fexp2(p0[r]); p1[r] = fexp2(p1[r]); s += p0[r] + p1[r]; }
    l += s;
}
__device__ __forceinline__ s16x4 vtr(const ldsp p) { typedef short v4i16_t __attribute__((ext_vector_type(4))); return __builtin_bit_cast(s16x4, __builtin_amdgcn_ds_read_tr16_b64_v4i16((LAS v4i16_t*)p)); }
__device__ __forceinline__ void pv_tile(f32x16 (&o)[2], const ldsp Vt, const f32x16& p0, const f32x16& p1, int lane, int hi) {
    u32x4 pw[4];
    pw[0] = (u32x4){pk2(p0[0], p0[1]), pk2(p0[2], p0[3]), pk2(p0[4], p0[5]), pk2(p0[6], p0[7])};
    pw[1] = (u32x4){pk2(p0[8], p0[9]), pk2(p0[10], p0[11]), pk2(p0[12], p0[13]), pk2(p0[14], p0[15])};
    pw[2] = (u32x4){pk2(p1[0], p1[1]), pk2(p1[2], p1[3]), pk2(p1[4], p1[5]), pk2(p1[6], p1[7])};
    pw[3] = (u32x4){pk2(p1[8], p1[9]), pk2(p1[10], p1[11]), pk2(p1[12], p1[13]), pk2(p1[14], p1[15])};
    const ldsp vp = Vt + ((lane >> 4) & 1) * 32 + (lane & 3) * 8 + (4 * hi + ((lane & 15) >> 2)) * 64;
    __builtin_amdgcn_s_setprio(1);
#pragma unroll
    for (int d0 = 0; d0 < 2; ++d0)
#pragma unroll
        for (int ks = 0; ks < 4; ++ks) {
            const s16x4 lo = vtr(vp + d0 * 4096 + ks * 1024), hh = vtr(vp + d0 * 4096 + ks * 1024 + 512);
            const bf16x8 vf = (bf16x8){lo[0], lo[1], lo[2], lo[3], hh[0], hh[1], hh[2], hh[3]};
            o[d0] = __builtin_amdgcn_mfma_f32_32x32x16_bf16(__builtin_bit_cast(bf16x8, pw[ks]), vf, o[d0], 0, 0, 0);
        }
    __builtin_amdgcn_s_setprio(0);
}
__device__ __forceinline__ void attn_step(const ldsp Kt, const ldsp Vt, const bf16x8 (&qr)[4], f32x16 (&o)[2], float& mref, f32x16& negm, float& l, int lo, int hq, bool en, bool first, LAS float* wsf, int lane, int r32, int hi) {
    f32x16 p0, p1;
    qk_tile(p0, p1, Kt, qr, negm, r32, hi);
    if (!__all(en)) { const float pen = en ? 0.f : NEG_INF;
#pragma unroll
        for (int r = 0; r < 16; ++r) { p0[r] += pen; p1[r] += pen; } }
    mask_tile(p0, p1, lo, hq, hi);
    sm_update(p0, p1, mref, negm, l, o, first, wsf, r32, hi);
    pv_tile(o, Vt, p0, p1, lane, hi);
}
__device__ __forceinline__ void rows_axpy(f32x16 (&acc)[2], const f32x16 (&o)[2], float f, LAS float* wsf, int r32, int hi, bool init) {
    LDS_WAIT();
    if (hi == 0) wsf[r32] = f;
    LDS_WAIT();
#pragma unroll
    for (int r = 0; r < 16; ++r) { const float g = wsf[crow(r, hi)];
        if (init) { acc[0][r] = o[0][r] * g; acc[1][r] = o[1][r] * g; } else { acc[0][r] += o[0][r] * g; acc[1][r] += o[1][r] * g; } }
    LDS_WAIT();
}

template <class F> __device__ __forceinline__ void stage_store(const f32x16 (&ot)[2], ldsp lds, int w, int lane, int r32, int hi, F rowp) {
    LAS float* stg = (LAS float*)(lds + 65536 + w * 8704);
#pragma unroll
    for (int d0 = 0; d0 < 2; ++d0)
#pragma unroll
        for (int r = 0; r < 16; ++r) stg[crow(r, hi) * 68 + d0 * 32 + r32] = ot[d0][r];
    LDS_WAIT();
#pragma unroll
    for (int i = 0; i < 4; ++i) {
        const int row = i * 8 + (lane >> 3);
        const f32x4 x0 = *(const LAS f32x4*)(stg + row * 68 + (lane & 7) * 8), x1 = *(const LAS f32x4*)(stg + row * 68 + (lane & 7) * 8 + 4);
        u32x4 ow; ow.x = pk2(x0[0], x0[1]); ow.y = pk2(x0[2], x0[3]); ow.z = pk2(x1[0], x1[1]); ow.w = pk2(x1[2], x1[3]);
        *(GAS u32x4*)(rowp(row) + (lane & 7) * 8) = ow;
    }
    LDS_WAIT();
}

__device__ __forceinline__ void b_unit(const bf16_t* Z, bf16_t* MIX, const float* sinks, ldsp lds, int b, int kvh, int qb, unsigned& gt, int wave0) {
    int tid_; asm volatile("v_mbcnt_lo_u32_b32 %0, -1, 0\n\tv_mbcnt_hi_u32_b32 %0, -1, %0" : "=&v"(tid_)); tid_ += wave0 * 64; const int tid = tid_, lane = tid & 63, w = __builtin_amdgcn_readfirstlane(tid >> 6), r32 = lane & 31, hi = lane >> 5;
    const int g = r32 >> 3, qq = r32 & 7, tq = 64 * qb + 8 * w + qq, head = kvh * 4 + g, key = tid >> 3, ch = tid & 7;
    LAS float* wsf = (LAS float*)(lds + LDS_WSF) + w * 64;
    const size_t tok = (size_t)b * T + tq;
    bf16x8 qr[4]; q_load(qr, Z + tok * ZP0 + C_BQ + head * 64, hi);
    float m = *(const GAS float*)(sinks + head) * LOG2E, l = (hi == 0) ? 1.f : 0.f;
    f32x16 o[2], negm; splat16(negm, -m);
    splat16(o[0], 0.f); splat16(o[1], 0.f);
    const int n0 = qb >= 2 ? qb - 2 : 0;
    const bf16_t* kvp = Z + ((size_t)b * T + key) * ZP0 + kvh * 64 + ch * 8;
    u32x4 rk0 = ldg16(kvp + (size_t)(64 * n0) * ZP0 + C_BK), rv0 = ldg16(kvp + (size_t)(64 * n0) * ZP0 + C_BV), rk1 = rk0, rv1 = rv0;
    if (n0 + 1 <= qb) { rk1 = ldg16(kvp + (size_t)(64 * (n0 + 1)) * ZP0 + C_BK); rv1 = ldg16(kvp + (size_t)(64 * (n0 + 1)) * ZP0 + C_BV); }
    tile_store(lds + (gt & 1u) * 16384, rk0, rv0, key, ch);
    if (n0 + 2 <= qb) { rk0 = ldg16(kvp + (size_t)(64 * (n0 + 2)) * ZP0 + C_BK); rv0 = ldg16(kvp + (size_t)(64 * (n0 + 2)) * ZP0 + C_BV); }
    __syncthreads();
#define B_STEP(n, RK, RV) do { \
        const ldsp buf = lds + (gt & 1u) * 16384, nxt = lds + ((gt + 1u) & 1u) * 16384; \
        if ((n) < qb) tile_store(nxt, RK, RV, key, ch); \
        if ((n) + 3 <= qb) { RK = ldg16(kvp + (size_t)(64 * ((n) + 3)) * ZP0 + C_BK); RV = ldg16(kvp + (size_t)(64 * ((n) + 3)) * ZP0 + C_BV); } \
        attn_step(buf, buf + 8192, qr, o, m, negm, l, tq - 127 - 64 * (n), tq - 64 * (n), true, false, wsf, lane, r32, hi); \
        __syncthreads(); ++gt; } while (0)
    for (int n = n0; n <= qb; n += 2) { B_STEP(n, rk1, rv1); if (n + 1 <= qb) B_STEP(n + 1, rk0, rv0); }
#undef B_STEP
    const float lt = xh_sum(l);
    f32x16 ot[2];
    rows_axpy(ot, o, 1.0f / lt, wsf, r32, hi, true);
    stage_store(ot, lds, w, lane, r32, hi, [=](int q) { return MIX + ((size_t)b * T + 64 * qb + 8 * w + (q & 7)) * 1024 + 512 + (kvh * 4 + (q >> 3)) * 64; });
}

__device__ __forceinline__ void nsa_unit(const bf16_t* Z, const bf16_t* KVC, bf16_t* MIX, ldsp lds, int b, int kvh, int qb, unsigned& gt, int wave0) {
    int tid_; asm volatile("v_mbcnt_lo_u32_b32 %0, -1, 0\n\tv_mbcnt_hi_u32_b32 %0, -1, %0" : "=&v"(tid_)); tid_ += wave0 * 64; const int tid = tid_, lane = tid & 63, w = __builtin_amdgcn_readfirstlane(tid >> 6), r32 = lane & 31, hi = lane >> 5;
    const int g = r32 >> 3, qq = r32 & 7, tq = 64 * qb + 8 * w + qq, head = kvh * 4 + g, key = tid >> 3, ch = tid & 7;
    LAS float* wsf = (LAS float*)(lds + LDS_WSF) + w * 64;
    const size_t tok = (size_t)b * T + tq;
    const bf16_t* zrow = Z + tok * ZP0;
    const int nct = (4 * qb + 3 + 63) >> 6;
    {
        const bf16_t* kv = KVC + ((size_t)(b * 2 + kvh) * 256 + key) * 512 + ch * 8;
        for (int ct = 0; ct < nct; ++ct) { const u32x4 k = ldg16(kv + (size_t)ct * 64 * 512), v = ldg16(kv + (size_t)ct * 64 * 512 + 256); tile_store(lds + ct * 16384, k, v, key, ch); }
    }
    const GAS bf16_t* zg = (const GAS bf16_t*)(zrow + C_GATE + head * 3);
    const unsigned gpk = (unsigned)zg[0] | ((unsigned)zg[1] << 16), gp2 = (unsigned)zg[2];
#define GATE0() sigmoid_f(__builtin_bit_cast(float, gpk << 16))
#define GATE1() sigmoid_f(__builtin_bit_cast(float, gpk & 0xffff0000u))
#define GATE2() sigmoid_f(__builtin_bit_cast(float, gp2 << 16))
    bf16x8 qr[4]; q_load(qr, zrow + C_AQP + head * 64, hi);
    __syncthreads();
    float m = 0.f, l = 0.f;
    f32x16 o[2], ot[2], negm; splat16(negm, 0.f);
    splat16(o[0], 0.f); splat16(o[1], 0.f);
    const int cmax = (tq - 31) >> 4;
    for (int ct = 0; ct < nct; ++ct) attn_step(lds + ct * 16384, lds + ct * 16384 + 8192, qr, o, m, negm, l, 0, cmax - 64 * ct, true, ct == 0, wsf, lane, r32, hi);
    const float ltc = xh_sum(l), inv = ltc > 0.f ? 1.0f / ltc : 0.f;
    unsigned long long selmask = ~0ull;
    if (qb >= 16) {
        LAS float* G = (LAS float*)(lds + LDS_NSA_IMP + w * NSA_IMP_STRIDE); LAS float* L = G + 512;
        for (int ct = 0; ct < nct; ++ct) {
            f32x16 p0, p1;
            qk_tile(p0, p1, lds + ct * 16384, qr, negm, r32, hi);
            mask_tile(p0, p1, 0, cmax - 64 * ct, hi);
#pragma unroll
            for (int r = 0; r < 16; ++r) { p0[r] = fexp2(p0[r]) * inv; p1[r] = fexp2(p1[r]) * inv; }
#pragma unroll
            for (int hf = 0; hf < 2; ++hf)
#pragma unroll
                for (int grp = 0; grp < 4; ++grp) {
                    float gs, ls;
                    if (hf == 0) { gs = (p0[4 * grp] + p0[4 * grp + 1]) + (p0[4 * grp + 2] + p0[4 * grp + 3]); ls = p0[4 * grp + 3]; }
                    else         { gs = (p1[4 * grp] + p1[4 * grp + 1]) + (p1[4 * grp + 2] + p1[4 * grp + 3]); ls = p1[4 * grp + 3]; }
                    gs += __shfl_xor(gs, 8); gs += __shfl_xor(gs, 16); ls += __shfl_xor(ls, 8); ls += __shfl_xor(ls, 16);
                    const int n = ct * 16 + hf * 8 + 2 * grp + hi;
                    if (g == 0) { G[qq * 64 + n] = gs; L[qq * 68 + n + 1] = ls; }
                }
        }
        LDS_WAIT();
#pragma unroll 1
        for (int q8 = 0; q8 < 8; ++q8) {
            float v = G[q8 * 64 + lane] + (lane > 0 ? L[q8 * 68 + lane] : 0.f);
            v = (lane > qb) ? -1.f : v;
            v = (lane == 0) ? 3e38f : (lane == qb) ? 2e38f : (lane == qb - 1) ? 1e38f : v;
            int rank = 0;
#pragma unroll
            for (int j = 0; j < 64; ++j) { const float vj = __uint_as_float(__builtin_amdgcn_readlane(__float_as_uint(v), j)); rank += (vj > v) ? 1 : 0; }
            const unsigned long long mk = __ballot(rank < 16);
            if (qq == q8) selmask = mk;
        }
    }
    rows_axpy(ot, o, GATE0() * inv, wsf, r32, hi, true);
    q_load(qr, zrow + C_AQR + head * 64, hi);
    const int ns = qb + 1, w0 = qb >= 8 ? qb - 8 : 0, ntile = ns + (qb - w0 + 1);
    m = 0.f; l = 0.f; splat16(negm, 0.f);
    splat16(o[0], 0.f); splat16(o[1], 0.f);
    const bf16_t* kvp = Z + ((size_t)b * T + key) * ZP0 + kvh * 64 + ch * 8;
#define NSA_LOAD(j, RK, RV) do { const bool nw_ = (j) >= ns; const int nn_ = nw_ ? w0 + (j) - ns : (j); \
        RK = ldg16(kvp + (size_t)(64 * nn_) * ZP0 + (nw_ ? C_AKW : C_AKS)); RV = ldg16(kvp + (size_t)(64 * nn_) * ZP0 + (nw_ ? C_AVW : C_AVS)); } while (0)
    u32x4 rk0, rv0, rk1, rv1;
    NSA_LOAD(0, rk0, rv0); NSA_LOAD(1, rk1, rv1);
    tile_store(lds + LDS_NSA_RING + (gt & 1u) * 16384, rk0, rv0, key, ch);
    if (2 < ntile) NSA_LOAD(2, rk0, rv0);
    __syncthreads();
    LAS float* slab = (LAS float*)(lds + w * 8192) + lane;
#pragma unroll
    for (int k = 0; k < 16; ++k) { slab[k * 64] = ot[0][k]; slab[(16 + k) * 64] = ot[1][k]; }
#define NSA_STEP(i, RK, RV) do { \
        const bool isw = (i) >= ns; const int n = isw ? w0 + (i) - ns : (i); \
        const ldsp buf = lds + LDS_NSA_RING + (gt & 1u) * 16384, nxt = lds + LDS_NSA_RING + ((gt + 1u) & 1u) * 16384; \
        if ((i) + 1 < ntile) tile_store(nxt, RK, RV, key, ch); \
        if ((i) + 3 < ntile) NSA_LOAD((i) + 3, RK, RV); \
        if ((i) == ns) { \
            const float lt = xh_sum(l); f32x16 t2[2]; \
            rows_axpy(t2, o, GATE1() / lt, wsf, r32, hi, true); \
            _Pragma("unroll") for (int k = 0; k < 16; ++k) { slab[k * 64] += t2[0][k]; slab[(16 + k) * 64] += t2[1][k]; } \
            m = 0.f; l = 0.f; splat16(negm, 0.f); \
            splat16(o[0], 0.f); splat16(o[1], 0.f); \
        } \
        const bool en = isw ? true : (((selmask >> n) & 1ull) != 0ull); \
        const int lo = isw ? tq - 511 - 64 * n : 0, hq = tq - 64 * n; \
        if (__any(en)) attn_step(buf, buf + 8192, qr, o, m, negm, l, lo, hq, en, (i) == 0 || (i) == ns, wsf, lane, r32, hi); \
        __syncthreads(); ++gt; } while (0)
    for (int i = 0; i < ntile; i += 2) { NSA_STEP(i, rk1, rv1); if (i + 1 < ntile) NSA_STEP(i + 1, rk0, rv0); }
#undef NSA_STEP
#undef NSA_LOAD
    {
        const float lt = xh_sum(l);
        rows_axpy(ot, o, GATE2() / lt, wsf, r32, hi, true);
#pragma unroll
        for (int k = 0; k < 16; ++k) { ot[0][k] += slab[k * 64]; ot[1][k] += slab[(16 + k) * 64]; }
    }
    stage_store(ot, lds, w, lane, r32, hi, [=](int q) { return MIX + ((size_t)b * T + 64 * qb + 8 * w + (q & 7)) * 1024 + (kvh * 4 + (q >> 3)) * 64; });
    __syncthreads();
#undef GATE0
#undef GATE1
#undef GATE2
}

__device__ __forceinline__ void c_phase(const bf16_t* Z, bf16_t* MIX, float* LSE, ldsp lds, int pi, int bx, int G, unsigned& gt, int wave0, int ucount) {
    int tid_; asm volatile("v_mbcnt_lo_u32_b32 %0, -1, 0\n\tv_mbcnt_hi_u32_b32 %0, -1, %0" : "=&v"(tid_)); tid_ += wave0 * 64; const int tid = tid_, lane = tid & 63, w = __builtin_amdgcn_readfirstlane(tid >> 6), r32 = lane & 31, hi = lane >> 5;
    const int hsel = w >> 2, gq = (w < 4) ? w : 7 - w, key = tid >> 3, ch = tid & 7;
    const int ldil = 2 * pi, dil = 1 << ldil, lnb = 5 - ldil;
    LAS float* wsf = (LAS float*)(lds + LDS_WSF) + w * 64;
    const size_t tstride = (size_t)64 * dil * 64;
    const unsigned kvlane = (unsigned)(key * dil * 64 + ch * 8), qlane = (unsigned)(r32 * dil * 64), olane = (unsigned)((lane >> 3) * dil * 1024 + (lane & 7) * 8), llane = (unsigned)(r32 * dil * 16);
#define C_DEC(u_, b_, hp_, rs_, blk_) const int blk_ = (u_) & ((1 << lnb) - 1), rs_ = ((u_) >> lnb) & (dil - 1), hp_ = ((u_) >> 5) & 7, b_ = (u_) >> 8
#define C_KVP(b_, hp_, rs_) (Z + ((size_t)(((b_) * 3 + 1) * 16 + 2 * (hp_)) * T + (rs_)) * 64)
#define C_QROW(b_, hp_, rs_, blk_) (Z + ((size_t)(((b_) * 3) * 16 + 2 * (hp_) + hsel) * T + (size_t)(128 * (blk_) + 32 * gq) * dil + (rs_)) * 64 + qlane)
#define C_LOADP(p_) do { const bf16_t* q_ = (p_); rka = ldg16(q_ + kvlane); rva = ldg16(q_ + (size_t)16 * T * 64 + kvlane); rkb = ldg16(q_ + (size_t)T * 64 + kvlane); rvb = ldg16(q_ + (size_t)17 * T * 64 + kvlane); } while (0)
    const u32x4 z4 = {0u, 0u, 0u, 0u};
    u32x4 rka = z4, rva = z4, rkb = z4, rvb = z4;
    const int per = (ucount + G - 1) / G, uend = (bx + 1) * per < ucount ? (bx + 1) * per : ucount;
    int u = bx * per;
    if (u >= uend) return;
    {   C_DEC(u, b, hp, rs, blk); const int kt0 = blk >= 1 ? 2 * blk - 2 : 0; const bf16_t* kvp = C_KVP(b, hp, rs);
        C_LOADP(kvp + kt0 * tstride);
        { const ldsp b0 = lds + (gt & 1u) * 32768; tile_store(b0, rka, rva, key, ch); tile_store(b0 + 16384, rkb, rvb, key, ch); }
        C_LOADP(kvp + (kt0 + 1) * tstride);
        __syncthreads(); }
    for (; u < uend; ++u) {
        C_DEC(u, b, hp, rs, blk);
        const int head = 2 * hp + hsel, q0 = 128 * blk + 32 * gq, ql = q0 + r32;
        const int kt0 = blk >= 1 ? 2 * blk - 2 : 0, kt1 = 2 * blk + 1;
        const bf16_t* kvp = C_KVP(b, hp, rs);
        const bool has_next = u + 1 < uend;
        const int un = has_next ? u + 1 : u;
        C_DEC(un, bn, hpn, rsn, blkn);
        const int kt0n = blkn >= 1 ? 2 * blkn - 2 : 0;
        const bf16_t* kvpn = C_KVP(bn, hpn, rsn) + kt0n * tstride;
        bf16x8 qr[4]; q_load(qr, C_QROW(b, hp, rs, blk), hi);
        GAS float* lsep = (GAS float*)(LSE + ((size_t)b * T + (size_t)q0 * dil + rs) * 16 + head + llane);
        bf16_t* orow = MIX + ((size_t)b * T + (size_t)q0 * dil + rs) * 1024 + head * 64 + olane;
        const size_t ostep = (size_t)8 * dil * 1024;
        u32x4 orun[4] = {z4, z4, z4, z4}; float lse_old = 0.f;
        float m = 0.f, l = 0.f; bool started = false;
        f32x16 o[2], negm; splat16(negm, 0.f);
        splat16(o[0], 0.f); splat16(o[1], 0.f);
        for (int kt = kt0; kt <= kt1; ++kt) {
            const ldsp buf = lds + (gt & 1u) * 32768, nxt = lds + ((gt + 1u) & 1u) * 32768;
            if (kt == kt1 - 1) {
                if (pi > 0) { lse_old = *lsep;
#pragma unroll
                    for (int i = 0; i < 4; ++i) orun[i] = ldg16(orow + i * ostep); }
            }
            if (64 * kt <= q0 + 31 && 64 * kt + 63 >= q0 - 128) {
                attn_step(buf + hsel * 16384, buf + hsel * 16384 + 8192, qr, o, m, negm, l, ql - 128 - 64 * kt, ql - 64 * kt, true, !started, wsf, lane, r32, hi); started = true; }
            if (kt < kt1 || has_next) { tile_store(nxt, rka, rva, key, ch); tile_store(nxt + 16384, rkb, rvb, key, ch); }
            if (kt + 2 <= kt1) C_LOADP(kvp + (kt + 2) * tstride);
            else if (has_next) { if (kt == kt1 - 1) C_LOADP(kvpn); else C_LOADP(kvpn + tstride); }
            __syncthreads(); ++gt;
        }
        const float lt = xh_sum(l), lse = m + __log2f(lt);
        float wa = 0.f, wb = 1.0f / lt;
        if (pi > 0) {
            const float mx = fmaxf(lse_old, lse), nl = mx + __log2f(fexp2(lse_old - mx) + fexp2(lse - mx));
            wa = fexp2(lse_old - nl); wb = fexp2(lse - nl) / lt;
            if (pi < 2 && hi == 0) *lsep = nl;
        } else if (hi == 0) *lsep = lse;
        LDS_WAIT();
        if (hi == 0) { wsf[r32] = wa; wsf[32 + r32] = wb; }
        LDS_WAIT();
        LAS float* stg = (LAS float*)(lds + 65536 + w * 8704);
#pragma unroll
        for (int d0 = 0; d0 < 2; ++d0)
#pragma unroll
            for (int r = 0; r < 16; ++r) { const int q = crow(r, hi); stg[q * 68 + d0 * 32 + r32] = wsf[32 + q] * o[d0][r]; }
        LDS_WAIT();
#pragma unroll
        for (int i = 0; i < 4; ++i) {
            const int row = i * 8 + (lane >> 3);
            const f32x4 x0 = *(const LAS f32x4*)(stg + row * 68 + (lane & 7) * 8), x1 = *(const LAS f32x4*)(stg + row * 68 + (lane & 7) * 8 + 4);
            float v[8] = {x0[0], x0[1], x0[2], x0[3], x1[0], x1[1], x1[2], x1[3]};
            if (pi > 0) { const float fa = wsf[row];
#pragma unroll
                for (int k = 0; k < 4; ++k) { const unsigned wd = orun[i][k]; v[2 * k] += fa * __builtin_bit_cast(float, wd << 16); v[2 * k + 1] += fa * __builtin_bit_cast(float, wd & 0xffff0000u); } }
            u32x4 ow; ow.x = pk2(v[0], v[1]); ow.y = pk2(v[2], v[3]); ow.z = pk2(v[4], v[5]); ow.w = pk2(v[6], v[7]);
            *(GAS u32x4*)(orow + i * ostep) = ow;
        }
        LDS_WAIT();
    }
#undef C_DEC
#undef C_KVP
#undef C_QROW
#undef C_LOADP
}
__device__ __forceinline__ int il64(int p) { return (p & 1) ? (p >> 1) + 32 : (p >> 1); }
__device__ __forceinline__ int src_col(int mapid, int n) {
    switch (mapid) {
    case 0:
        if (n < 512) return (n & ~63) + il64(n & 63);
        if (n < 768) return n;
        if (n < 896) return (n & ~63) + il64(n & 63);
        if (n < 1024) return n;
        if (n < 1152) return (n & ~63) + il64(n & 63);
        if (n < 1280) return n;
        if (n < 1792) { const int q = n - 1280; return 1304 + (q & ~63) + il64(q & 63); }
        if (n < 1920) { const int q = n - 1792; return 1816 + (q & ~63) + il64(q & 63); }
        if (n < 2048) return 1944 + (n - 1920);
        if (n < 2072) return 1280 + (n - 2048);
        return -1;
    case 2: return n < 2048 ? (n & ~63) + il64(n & 63) : n;
    case 3: { const int hid = (n >> 8) * 128 + (n & 127); return ((n >> 7) & 1) ? FF + hid : hid; }
    case 4: return n < 64 ? il64(n) : -1;
    case 5: return n < 64 ? n : -1;
    default: return n;
    }
}
__device__ __forceinline__ void tr_item(const float* W, int K, int Nlog, const float* gain, bf16_t* Wt, int mapid, int nblk, LAS float* scr, int item, int lane) {
    const int kb = item / nblk, nb = item % nblk, k0 = 64 * kb, n0 = 32 * nb;
    const int src = src_col(mapid, n0 + (lane & 31));
#pragma unroll 8
    for (int i = 0; i < 32; ++i) { const int kk = 2 * i + (lane >> 5); float v = 0.f;
        if (src >= 0) { v = *(const GAS float*)(W + (size_t)(k0 + kk) * Nlog + src); if (gain) v *= *(const GAS float*)(gain + k0 + kk); }
        scr[kk * 33 + (lane & 31)] = v; }
    LDS_WAIT();
    const int c = lane & 7;
#pragma unroll
    for (int j = 0; j < 4; ++j) { const int n = (lane >> 3) + 8 * j; const LAS float* s = scr + (8 * c) * 33 + n;
        u32x4 o; o.x = pk2(s[0 * 33], s[1 * 33]); o.y = pk2(s[2 * 33], s[3 * 33]); o.z = pk2(s[4 * 33], s[5 * 33]); o.w = pk2(s[6 * 33], s[7 * 33]);
        *(GAS u32x4*)(Wt + (size_t)(n0 + n) * K + k0 + 8 * c) = o; }
    LDS_WAIT();
}
__device__ __forceinline__ void row_to_bf16_ss(const float* xrow, bf16_t* orow, float* ssrow, int lane) {
    const GAS f32x4* xr = (const GAS f32x4*)xrow + 2 * lane;
    f32x4 v[4]; float s = 0.f;
#pragma unroll
    for (int j = 0; j < 2; ++j) { v[2 * j] = xr[128 * j]; v[2 * j + 1] = xr[128 * j + 1]; }
#pragma unroll
    for (int j = 0; j < 4; ++j) s += (v[j].x * v[j].x + v[j].y * v[j].y) + (v[j].z * v[j].z + v[j].w * v[j].w);
    s = wave_sum(s);
    GAS u32x4* o16 = (GAS u32x4*)orow + lane;
#pragma unroll
    for (int j = 0; j < 2; ++j) { u32x4 w; w.x = pk2(v[2 * j].x, v[2 * j].y); w.y = pk2(v[2 * j].z, v[2 * j].w); w.z = pk2(v[2 * j + 1].x, v[2 * j + 1].y); w.w = pk2(v[2 * j + 1].z, v[2 * j + 1].w); o16[64 * j] = w; }
    if (lane < 16) *(GAS float*)(ssrow + lane) = (lane == 0) ? s : 0.f;
}
__device__ __forceinline__ void rms_row_final(const bf16_t* xbrow, float* orow, const float* gain, const float* ssrow, int lane) {
    GAS f32x4* xo = (GAS f32x4*)orow + 2 * lane; const GAS f32x4* gr = (const GAS f32x4*)gain + 2 * lane; const GAS u32x4* xr = (const GAS u32x4*)xbrow + lane;
    u32x4 h[2];
#pragma unroll
    for (int j = 0; j < 2; ++j) h[j] = xr[64 * j];
    const float s = lane < 16 ? *(const GAS float*)(ssrow + lane) : 0.f;
    const float rstd = 1.0f / sqrtf(wave_sum(s) * (1.0f / D) + NORM_EPS);
#pragma unroll
    for (int j = 0; j < 2; ++j) {
        const f32x4 a = (f32x4){__builtin_bit_cast(float, h[j].x << 16), __builtin_bit_cast(float, h[j].x & 0xffff0000u), __builtin_bit_cast(float, h[j].y << 16), __builtin_bit_cast(float, h[j].y & 0xffff0000u)};
        const f32x4 b = (f32x4){__builtin_bit_cast(float, h[j].z << 16), __builtin_bit_cast(float, h[j].z & 0xffff0000u), __builtin_bit_cast(float, h[j].w << 16), __builtin_bit_cast(float, h[j].w & 0xffff0000u)};
        xo[128 * j] = (a * rstd) * gr[128 * j]; xo[128 * j + 1] = (b * rstd) * gr[128 * j + 1]; }
}
__device__ __forceinline__ void sincos_d(float a, float& c, float& s) {
    const double x = (double)a; const double kq = __builtin_rint(x * 0.63661977236758134308);
    double r = __builtin_fma(-kq, 1.57079632679489655800, x); r = __builtin_fma(-kq, 6.12323399573676603587e-17, r);
    const double r2 = r * r;
    const double sn = r * (1.0 + r2 * (-1.0 / 6 + r2 * (1.0 / 120 + r2 * (-1.0 / 5040 + r2 * (1.0 / 362880 + r2 * (-1.0 / 39916800 + r2 * (1.0 / 6227020800.0)))))));
    const double cs = 1.0 + r2 * (-0.5 + r2 * (1.0 / 24 + r2 * (-1.0 / 720 + r2 * (1.0 / 40320 + r2 * (-1.0 / 3628800 + r2 * (1.0 / 479001600.0 + r2 * (-1.0 / 87178291200.0)))))));
    const int q = (int)kq & 3;
    const double so = (q == 0) ? sn : (q == 1) ? cs : (q == 2) ? -sn : -cs, co = (q == 0) ? cs : (q == 1) ? -sn : (q == 2) ? -cs : sn;
    c = (float)co; s = (float)so;
}

typedef unsigned v4u __attribute__((ext_vector_type(4)));
#define XB_TMO      128
#define XB_XCNT(j)  (256  + 64 * (j))
#define XB_XSUB(j)  (1280 + 64 * (j))
#define XB_XGEN(j)  (2304 + 64 * (j))
#define XB_TOP      3328
#define XB_TOPGEN   3392
#define XCD_BAR_WORDS 3456
#define XB_SPIN_CAP (1u << 18)

__device__ __forceinline__ unsigned xb_ld(unsigned* p)              { return __hip_atomic_load(p, __ATOMIC_RELAXED, __HIP_MEMORY_SCOPE_AGENT); }
__device__ __forceinline__ unsigned xb_add(unsigned* p, unsigned v) { return __hip_atomic_fetch_add(p, v, __ATOMIC_RELAXED, __HIP_MEMORY_SCOPE_AGENT); }
__device__ __forceinline__ unsigned xb_xcc_id() { return (unsigned)__builtin_amdgcn_s_getreg((3 << 11) | 20) & 0xFu; }
#define XB_SPIN(cond, bar) do { unsigned _sp = 0; while (cond) { __builtin_amdgcn_s_sleep(1); \
    if ((++_sp & 255u) == 0u) { if (xb_ld(&(bar)[XB_TMO])) break; if (_sp > XB_SPIN_CAP) { atomicAdd(&(bar)[XB_TMO], 1u); break; } } } } while (0)

struct XcdBarrier {
    unsigned* bar; unsigned x; int w0;
    volatile LAS unsigned* st;
};

__device__ __forceinline__ bool xb_thread0(int w0) { return w0 == 0 && __builtin_amdgcn_mbcnt_hi(~0u, __builtin_amdgcn_mbcnt_lo(~0u, 0u)) == 0u; }
__device__ __forceinline__ XcdBarrier xcd_barrier_post(unsigned* bar, volatile LAS unsigned* st, int w0) {
    XcdBarrier b; b.bar = bar; b.x = xb_xcc_id(); b.st = st; b.w0 = w0;
    if (xb_thread0(w0)) (void)xb_add(&bar[XB_XCNT(b.x)], 1u);
    return b;
}
__device__ __forceinline__ void xcd_barrier_complete(unsigned* bar, unsigned x, unsigned& nloc, unsigned& nx) {
    const unsigned G = gridDim.x * gridDim.y * gridDim.z;
    unsigned sum, cnt, mine, sp = 0u;
    for (;;) {
        sum = 0u; cnt = 0u; mine = 0u;
#pragma unroll
        for (unsigned j = 0; j < 16; ++j) { const unsigned c = xb_ld(&bar[XB_XCNT(j)]); sum += c; cnt += (c > 0u) ? 1u : 0u; mine = (j == x) ? c : mine; }
        if (sum == G) break;
        __builtin_amdgcn_s_sleep(1);
        if ((++sp & 255u) == 0u) { if (xb_ld(&bar[XB_TMO])) break; if (sp > XB_SPIN_CAP) { atomicAdd(&bar[XB_TMO], 1u); break; } }
    }
    nloc = mine > 0u ? mine : 1u; nx = cnt > 0u ? cnt : 1u;
}

__device__ __forceinline__ void xcd_barrier(const XcdBarrier& b) {
    asm volatile("s_waitcnt vmcnt(0)" ::: "memory");
    __syncthreads();
    if (xb_thread0(b.w0)) {
        unsigned* bar = b.bar;
        __builtin_amdgcn_s_waitcnt(0);
        unsigned nloc = b.st[0], nx = b.st[1];
        if (nloc == 0u) { xcd_barrier_complete(bar, b.x, nloc, nx); b.st[0] = nloc; b.st[1] = nx; }
        const unsigned old = xb_add(&bar[XB_XSUB(b.x)], 1u);
        const unsigned gen = old / nloc;
        if (old + 1u == (gen + 1u) * nloc) {
            __builtin_amdgcn_fence(__ATOMIC_RELEASE, "agent");
            asm volatile("s_waitcnt vmcnt(0)" ::: "memory");
            const unsigned og = xb_add(&bar[XB_TOP], 1u);
            const unsigned tg = og / nx;
            if (og + 1u == (tg + 1u) * nx) xb_add(&bar[XB_TOPGEN], 1u);
            else XB_SPIN(xb_ld(&bar[XB_TOPGEN]) == tg, bar);
            __builtin_amdgcn_fence(__ATOMIC_ACQUIRE, "agent");
            xb_add(&bar[XB_XGEN(b.x)], 1u);
            asm volatile("s_waitcnt vmcnt(0)" ::: "memory");
        } else {
            XB_SPIN(xb_ld(&bar[XB_XGEN(b.x)]) == gen, bar);
            __builtin_amdgcn_fence(__ATOMIC_ACQUIRE, "agent");
            asm volatile("s_waitcnt vmcnt(0)" ::: "memory");
        }
    }
    __syncthreads();
}

__global__ void __launch_bounds__(512, 2) fwd_mega(Params P) {
    extern __shared__ __attribute__((aligned(16))) unsigned char lds_raw[];
    cg::grid_group grid = cg::this_grid();
    const ldsp lds = (ldsp)lds_raw;
    const int G = gridDim.x, bx = blockIdx.x, NGW = G * 8;
    const int wave0 = __builtin_amdgcn_readfirstlane((int)threadIdx.x >> 6);
#define TID_SETUP() int tid_; asm volatile("v_mbcnt_lo_u32_b32 %0, -1, 0\n\tv_mbcnt_hi_u32_b32 %0, -1, %0" : "=&v"(tid_)); tid_ += wave0 * 64; const int tid = tid_, lane = tid & 63, wave = __builtin_amdgcn_readfirstlane(tid >> 6), gw = bx * 8 + wave; (void)lane; (void)gw
#define WS_SETUP() unsigned char* ws = P.ws; asm volatile("" : "+s"(ws)); \
    float* cosT = (float*)(ws + WS_COS); float* sinT = (float*)(ws + WS_SIN); float* bias1 = (float*)(ws + WS_BIAS1); float* LSE = (float*)(ws + WS_LSE); \
    bf16_t* HID = (bf16_t*)(ws + WS_HID); bf16_t* KVC = (bf16_t*)(ws + WS_KVC); bf16_t* XN = (bf16_t*)(ws + WS_XN); bf16_t* MIX = XN; bf16_t* Z = (bf16_t*)(ws + WS_Z); bf16_t* H = Z; float* X = P.out; bf16_t* XB = (bf16_t*)(ws + WS_XB); float* SS = (float*)(ws + WS_SS); (void)XB; (void)SS; \
    (void)cosT; (void)sinT; (void)bias1; (void)LSE; (void)HID; (void)KVC; (void)XN; (void)MIX; (void)Z; (void)H; (void)X
    unsigned gt = 0;
    unsigned* barw = (unsigned*)(P.ws + WS_BAR);
    volatile LAS unsigned* barst = (volatile LAS unsigned*)(lds + LDS_BARST);
    { TID_SETUP();
    if (tid == 0) { barst[0] = 0u; barst[1] = 0u; }
    if (bx == 0) { for (int i = tid; i < XCD_BAR_WORDS; i += 512) __hip_atomic_store(barw + i, 0u, __ATOMIC_RELAXED, __HIP_MEMORY_SCOPE_AGENT); } }
    __syncthreads();

    {
        TID_SETUP(); WS_SETUP();
        LAS float* scr = (LAS float*)(lds + wave * 8704);
        constexpr int I0 = 16 * 72, I1 = 16 * 32, I2 = 16 * 96, I3 = 16 * 32, I4 = 16 * 176, I6 = 44 * 32, I8 = 32 * 8, I10 = 4 * 8;
        constexpr int NIT = I0 + I1 + I2 + I3 + 2 * I4 + 2 * I6 + 2 * I8 + 2 * I10;
        for (int it = gw; it < NIT; it += NGW) {
            int r = it;
            if (r < I0) { tr_item(P.in[4], 1024, 2072, P.in[1], (bf16_t*)(ws + W_IN), 0, 72, scr, r, lane); continue; } r -= I0;
            if (r < I1) { tr_item(P.in[5], 1024, 1024, nullptr, (bf16_t*)(ws + W_OUTE), 1, 32, scr, r, lane); continue; } r -= I1;
            if (r < I2) { tr_item(P.in[13], 1024, 3072, P.in[1] + 1024, (bf16_t*)(ws + W_QKV), 2, 96, scr, r, lane); continue; } r -= I2;
            if (r < I3) { tr_item(P.in[14], 1024, 1024, nullptr, (bf16_t*)(ws + W_OUTO), 1, 32, scr, r, lane); continue; } r -= I3;
            if (r < I4) { tr_item(P.in[15], 1024, 5632, P.in[2], (bf16_t*)(ws + W_GU0), 3, 176, scr, r, lane); continue; } r -= I4;
            if (r < I4) { tr_item(P.in[15] + (size_t)1024 * 5632, 1024, 5632, P.in[2] + 1024, (bf16_t*)(ws + W_GU1), 3, 176, scr, r, lane); continue; } r -= I4;
            if (r < I6) { tr_item(P.in[16], 2816, 1024, nullptr, (bf16_t*)(ws + W_DN0), 1, 32, scr, r, lane); continue; } r -= I6;
            if (r < I6) { tr_item(P.in[16] + (size_t)2816 * 1024, 2816, 1024, nullptr, (bf16_t*)(ws + W_DN1), 1, 32, scr, r, lane); continue; } r -= I6;
            if (r < I8) { tr_item(P.in[8], 2048, 256, nullptr, (bf16_t*)(ws + W_W1), 1, 8, scr, r, lane); continue; } r -= I8;
            if (r < I8) { tr_item(P.in[10], 2048, 256, nullptr, (bf16_t*)(ws + W_W1) + (size_t)256 * 2048, 1, 8, scr, r, lane); continue; } r -= I8;
            if (r < I10) { tr_item(P.in[9], 256, 64, nullptr, (bf16_t*)(ws + W_W2), 4, 8, scr, r, lane); continue; } r -= I10;
            tr_item(P.in[11], 256, 64, nullptr, (bf16_t*)(ws + W_W2) + (size_t)256 * 256, 5, 8, scr, r, lane);
        }
        for (int e = bx * 512 + tid; e < T * 32; e += G * 512) { const int t = e >> 5, i = e & 31; float c, s; sincos_d((float)t * P.inv_freq[i], c, s); cosT[e] = c; sinT[e] = s; }
        if (bx >= G - 32) {
            const int c = G - 1 - bx, j = tid; const float* pe = j < 256 ? P.in[6] : P.in[7]; const float* w1 = j < 256 ? P.in[8] : P.in[10];
            float s = 0.f;
#pragma unroll 16
            for (int kk = c * 64; kk < c * 64 + 64; ++kk) s += *(const GAS float*)(pe + kk) * *(const GAS float*)(w1 + (size_t)kk * 256 + (j & 255));
            *(GAS float*)(bias1 + 512 + c * 512 + j) = s;
        }
        for (int mrow = gw; mrow < M; mrow += NGW) row_to_bf16_ss(P.in[0] + (size_t)mrow * D, XB + (size_t)mrow * D, SS + (size_t)mrow * 16, lane);
    }
    grid.sync();
    const XcdBarrier xbar = xcd_barrier_post(barw, barst, wave0);
#define GRID_BAR() do { XcdBarrier t_ = xbar; asm volatile("" : "+s"(t_.x), "+s"(t_.bar)); xcd_barrier(t_); } while (0)
    {   WS_SETUP();
        if (bx == 0) { TID_SETUP(); float s = 0.f;
#pragma unroll 8
            for (int c = 0; c < 32; ++c) s += *(const GAS float*)(bias1 + 512 + c * 512 + tid);
            *(GAS float*)(bias1 + tid) = s; }
        pg8::Gemm g{XB, (const bf16_t*)(ws + W_IN), M, 2304, 1024, 1024, 128, 0, (long)256 * 1024 * 2, 0, 0};
        pg8::StaticOrder S; S.init(M, 2304, G, bx);
        const unsigned rope = 0xFu | (1u << 6) | (1u << 8) | (0xFu << 10) | (1u << 14), dual = 0xFu, scal = 0xFu | (0xFu << 10);
        EpiZ<0> E{Z, ZP0, rope, dual, scal, C_AQR, cosT, sinT, SS};
        pg8::gemm_phase<EpiZ<0>, pg8::StaticOrder, true, true>(lds, g, S, E, wave0);
    }
    GRID_BAR();
    {   WS_SETUP();
        pg8::Gemm g{Z, (const bf16_t*)(ws + W_W1), 32 * 256, 512, 2048, 16 * ZP0, ZP0 * 2, 1, (long)T * ZP0 * 2, 64 * 2, 128 * 2};
        g.A = Z + C_AKC;
        pg8::StaticOrder S; S.init(32 * 256, 512, G, bx);
        EpiB<1> E{HID, 512, bias1};
        pg8::gemm_phase<EpiB<1>, pg8::StaticOrder, true, true>(lds, g, S, E, wave0);
        asm volatile("s_waitcnt vmcnt(0)" ::: "memory");
        __builtin_amdgcn_fence(__ATOMIC_RELEASE, "agent"); __syncthreads(); __builtin_amdgcn_fence(__ATOMIC_ACQUIRE, "agent");
        {
            pg8::Gemm g2{HID, (const bf16_t*)(ws + W_W2), 32 * 256, 512, 256, 512, 128, 0, (long)256 * 512 * 2, 0, 256 * 2};
            EpiB<0> E2{KVC, 512, nullptr};
            pg8::gemm_phase<EpiB<0>, pg8::StaticOrder, true, true>(lds, g2, S, E2, wave0);
        }
        __syncthreads();
        if (G > 64) {
            if (bx < 64) { for (int j = 0; j < 2; ++j) { const int u = bx * 2 + j, qb = u & 63, bh = u >> 6; b_unit(Z, MIX, P.in[12], lds, bh >> 1, bh & 1, qb, gt, wave0); } }
            else { const int per_ = (1920 + (G - 64) - 1) / (G - 64), u0_ = 128 + (bx - 64) * per_, u1_ = (u0_ + per_ < 2048) ? u0_ + per_ : 2048;
                   for (int u = u0_; u < u1_; ++u) { const int qb = u & 63, bh = u >> 6; b_unit(Z, MIX, P.in[12], lds, bh >> 1, bh & 1, qb, gt, wave0); } }
        } else { for (int u = bx; u < 2048; u += G) { const int qb = u & 63, bh = u >> 6; b_unit(Z, MIX, P.in[12], lds, bh >> 1, bh & 1, qb, gt, wave0); } }
        __syncthreads();
    }
    GRID_BAR();
    {   WS_SETUP();
        for (int i = 0; i * G + bx < 2048; ++i) { const int u = i * G + bx, j = u >> 5, lvl = j & 7, rnd = j >> 3; const int qb = 63 - (8 * rnd + ((rnd & 1) ? 7 - lvl : lvl)); const int bh = u & 31;
            nsa_unit(Z, KVC, MIX, lds, bh >> 1, bh & 1, qb, gt, wave0); }
        __syncthreads();
    }
    GRID_BAR();
    {   WS_SETUP();
        pg8::Gemm g{MIX, (const bf16_t*)(ws + W_OUTE), M, 1024, 1024, 1024, 128, 0, (long)256 * 1024 * 2, 0, 0};
        pg8::StaticOrder S; S.init(M, 1024, G, bx);
        EpiRes<false> E{nullptr, XB, SS, 1024};
        pg8::gemm_phase<EpiRes<false>, pg8::StaticOrder, true, true>(lds, g, S, E, wave0);
    }
    GRID_BAR();
    for (int layer = 0; layer < 2; ++layer) {
        if (layer == 1) {
            {   WS_SETUP();
                pg8::Gemm g{XB, (const bf16_t*)(ws + W_QKV), M, 3072, 1024, 1024, 128, 0, (long)256 * 1024 * 2, 0, 0};
                pg8::StaticOrder S; S.init(M, 3072, G, bx);
                EpiZ<1> E{Z, ZP1, 0xFFFFu, 0u, 0xFFu, 0, cosT, sinT, SS};
                pg8::gemm_phase<EpiZ<1>, pg8::StaticOrder, true, true>(lds, g, S, E, wave0);
            }
            GRID_BAR();
            for (int pi = 0; pi < 3; ++pi) {
                WS_SETUP();
                c_phase(Z, MIX, LSE, lds, pi, bx, G, gt, wave0, 4096);
                __syncthreads();
                GRID_BAR();
            }
            {   WS_SETUP();
                pg8::Gemm g{MIX, (const bf16_t*)(ws + W_OUTO), M, 1024, 1024, 1024, 128, 0, (long)256 * 1024 * 2, 0, 0};
                pg8::StaticOrder S; S.init(M, 1024, G, bx);
                EpiRes<false> E{nullptr, XB, SS, 1024};
                pg8::gemm_phase<EpiRes<false>, pg8::StaticOrder, true, true>(lds, g, S, E, wave0);
            }
            GRID_BAR();
        }
        {   WS_SETUP();
            pg8::Gemm g{XB, (const bf16_t*)(ws + (layer == 0 ? W_GU0 : W_GU1)), M, 5632, 1024, 1024, 128, 0, (long)256 * 1024 * 2, 0, 0};
            pg8::StaticOrder S; S.init(M, 5632, G, bx);
            EpiSwiglu E{H, FF, SS};
            pg8::gemm_phase<EpiSwiglu, pg8::StaticOrder, true, true>(lds, g, S, E, wave0);
        }
        GRID_BAR();
        {   WS_SETUP();
            pg8::Gemm g{H, (const bf16_t*)(ws + (layer == 0 ? W_DN0 : W_DN1)), M, 1024, FF, FF, 128, 0, (long)256 * FF * 2, 0, 0};
            pg8::StaticOrder S; S.init(M, 1024, G, bx, 1);
            EpiRes<false> E{nullptr, XB, SS, 1024};
            pg8::gemm_phase<EpiRes<false>, pg8::StaticOrder, true, true>(lds, g, S, E, wave0);
        }
        GRID_BAR();
    }
    { TID_SETUP(); WS_SETUP();
    for (int mrow = gw; mrow < M; mrow += NGW) rms_row_final(XB + (size_t)mrow * D, X + (size_t)mrow * D, P.in[3], SS + (size_t)mrow * 16, lane); }
}

extern "C" void kernel_launch(void* const* d_in, const int* in_sizes, int n_in, void* d_out, int out_size, void* d_ws, size_t ws_size, hipStream_t stream) {
    static int grid = 0;
    if (grid == 0) {
        if (n_in != 17 || out_size != M * D || ws_size < WS_END) { fprintf(stderr, "kernel_launch: unexpected problem shape (n_in %d out %d ws %zu)\n", n_in, out_size, ws_size); grid = -1; return; }
        int dev = 0, cus = 0, per_cu = 0;
        hipGetDevice(&dev); hipDeviceGetAttribute(&cus, hipDeviceAttributeMultiprocessorCount, dev);
        hipFuncSetAttribute((const void*)fwd_mega, hipFuncAttributeMaxDynamicSharedMemorySize, LDS_BYTES);
        hipOccupancyMaxActiveBlocksPerMultiprocessor(&per_cu, (const void*)fwd_mega, 512, LDS_BYTES);
        if (per_cu < 1) { fprintf(stderr, "kernel_launch: occupancy query says %d blocks per CU\n", per_cu); per_cu = 1; }
        (void)hipGetLastError();
        grid = cus * 1;
    }
    if (grid < 0) return;
    Params p{};
    for (int i = 0; i < 17; ++i) p.in[i] = (const float*)d_in[i];
    p.out = (float*)d_out; p.ws = (unsigned char*)d_ws;
    for (int i = 0; i < 32; ++i) p.inv_freq[i] = 1.0f / powf(10000.0f, (float)(2 * i) / 64.0f);
    void* args[] = {&p};
    hipError_t e = hipLaunchCooperativeKernel((const void*)fwd_mega, dim3(grid), dim3(512), args, LDS_BYTES, stream);
    if (e != hipSuccess) fprintf(stderr, "cooperative launch failed: %s (grid %d)\n", hipGetErrorString(e), grid);
}
```

```cpp
#include <hip/hip_runtime.h>
#include <hip/hip_cooperative_groups.h>
#include <hip/hip_bf16.h>
#include <cstdio>
#include <cstdint>
namespace cg = cooperative_groups;
namespace pg8 {
#define PG8_LAS __attribute__((address_space(3)))
typedef unsigned short bf16_t;
typedef short bf16x8 __attribute__((ext_vector_type(8)));
typedef float f32x4 __attribute__((ext_vector_type(4)));
typedef unsigned u32x4 __attribute__((ext_vector_type(4)));
struct Unit { int pm, pn; };
constexpr int BM = 256, BK = 64, HALF = 128, HTB = HALF * BK * 2  , STAGE_BYTES = 8 * HTB, NXCD = 8, WGM = 4;

__host__ __device__ __forceinline__ int lds_byte(int r, int c) { const int st = (r >> 4) * 2 + (c >> 5), rr = r & 15, cc = c & 31, ob = rr * 64 + cc * 2; return st * 1024 + (ob ^ (((ob >> 9) & 1) << 5)); }
__host__ __device__ __forceinline__ void stage_rc(int b, int& R, int& C) { const int st = b / 1024, sb = b % 1024, swz = sb ^ (((sb >> 9) & 1) << 5); R = (st >> 1) * 16 + swz / 64; C = (st & 1) * 32 + (swz % 64) / 2; }
__host__ __device__ __forceinline__ int perm32(int rho) { const int n = rho >> 4, i = rho & 15; return 8 * (i >> 2) + 4 * n + (i & 3); }

struct Gemm { const bf16_t* A; const bf16_t* Bt; int M, N, K; int lda; int kstepA; int sh; long s1, s0, sp; };
__device__ __forceinline__ const char* a_base(const Gemm& g, const struct Unit& u);

struct StaticOrder {
    int nM, nN, nwg, G, c, rev;
    __host__ __device__ void init(int M, int N, int G_, int c_, int rev_ = 0) { nM = M / BM; nN = N / BM; nwg = nM * nN; G = G_; c = c_; rev = rev_; }
    __host__ __device__ bool next(int i, Unit& u) const {
        const long L = (long)i * G + c; if (L >= nwg) return false;
        int wgid = (int)L; { const int q = nwg / NXCD, r = nwg % NXCD, xcd = wgid % NXCD, off = wgid / NXCD; wgid = (xcd < r ? xcd * (q + 1) : r * (q + 1) + (xcd - r) * q) + off; }
        const int nig = WGM * nN, gid = wgid / nig, fm = gid * WGM, gsz = (nM - fm) < WGM ? (nM - fm) : WGM;
        u.pm = fm + ((wgid % nig) % gsz); u.pn = (wgid % nig) / gsz; if (rev) u.pm = nM - 1 - u.pm; return true;
    }
    __device__ __forceinline__ void a_ready(const Unit&) const {}
    __device__ __forceinline__ void done(const Unit&) const {}
};


__device__ __forceinline__ const char* a_base(const Gemm& g, const Unit& u) { return (const char*)g.A + (size_t)(u.pm >> g.sh) * g.s1 + (size_t)(u.pm & ((1 << g.sh) - 1)) * g.s0 + (size_t)u.pn * g.sp; }
template <class Epi, class Sched, bool ALIGN_EPI = false, bool SP2 = false>
__device__ __forceinline__ void gemm_phase(PG8_LAS unsigned char* lds, const Gemm g, const Sched& S, const Epi& E, int wave0) {
    int tid_; asm volatile("v_mbcnt_lo_u32_b32 %0, -1, 0\n\tv_mbcnt_hi_u32_b32 %0, -1, %0" : "=&v"(tid_)); tid_ += wave0 * 64; const int tid = tid_, wid = __builtin_amdgcn_readfirstlane(tid >> 6), lane = tid & 63, wr = wid >> 2, wc = wid & 3, fr = lane & 15, fq = lane >> 4;
    const int K = g.K, nt = K / BK;
    unsigned voffA[2], voffB[2];
#pragma unroll
    for (int i = 0; i < 2; ++i) { int R, C; stage_rc(tid * 16 + i * 8192, R, C); const int Rb = Epi::PERM ? ((R & ~31) + perm32(R & 31)) : R;
        voffA[i] = (unsigned)(R * g.lda + C) * 2u; voffB[i] = (unsigned)(Rb * K + C) * 2u; }
    const size_t kstep = (size_t)(BK * 2); const size_t kstepA = (size_t)g.kstepA; const size_t hstepA = (size_t)HALF * g.lda * 2;
    const size_t hstep = (size_t)HALF * K * 2;
    const size_t tstep = 2 * hstep;
    const unsigned ldsw = (unsigned)wid * 1024u;
    const int aoff = lds_byte(wr * 64 + fr, fq * 8), boff = lds_byte(wc * 32 + fr, fq * 8);
#define PG8_SA(b, h) (((b) * 2 + (h)) * HTB)
#define PG8_SB(b, h) ((4 + (b) * 2 + (h)) * HTB)
#define PG8_STAGE(bufoff, gbase, voff) do { _Pragma("unroll") for (int _i = 0; _i < 2; ++_i) \
        __builtin_amdgcn_global_load_lds((const unsigned*)((const char*)(gbase) + (voff)[_i]), (PG8_LAS unsigned*)(lds + (bufoff) + ldsw + _i * 8192), 16, 0, 0); } while (0)
#define PG8_LDA(dst, b, h) do { _Pragma("unroll") for (int m = 0; m < 4; ++m) _Pragma("unroll") for (int k = 0; k < 2; ++k) dst[m][k] = *(const PG8_LAS bf16x8*)(lds + PG8_SA(b, h) + aoff + m * 2048 + k * 1024); } while (0)
#define PG8_LDB(dst, b, h) do { _Pragma("unroll") for (int n = 0; n < 2; ++n) _Pragma("unroll") for (int k = 0; k < 2; ++k) dst[n][k] = *(const PG8_LAS bf16x8*)(lds + PG8_SB(b, h) + boff + n * 2048 + k * 1024); } while (0)
#define PG8_MMA(ai, bj, At, Bt) do { __builtin_amdgcn_s_setprio(1); _Pragma("unroll") for (int m = 0; m < 4; ++m) _Pragma("unroll") for (int n = 0; n < 2; ++n) _Pragma("unroll") for (int k = 0; k < 2; ++k) \
        acc[ai][bj][m][n] = __builtin_amdgcn_mfma_f32_16x16x32_bf16(Bt[n][k], At[m][k], acc[ai][bj][m][n], 0, 0, 0); __builtin_amdgcn_s_setprio(0); } while (0)
#define PG8_WAIT_V(n) asm volatile("s_waitcnt vmcnt(" #n ")" ::: "memory")
#define PG8_WAIT_L(n) asm volatile("s_waitcnt lgkmcnt(" #n ")" ::: "memory")
#define PG8_BAR __builtin_amdgcn_s_barrier()
#define PG8_SCHED __builtin_amdgcn_sched_barrier(0)
    Unit cur, nxt; int ui = 0;
    if (!S.next(0, cur)) return;
    f32x4 acc[2][2][4][2];
#pragma unroll
    for (int a = 0; a < 2; ++a)
#pragma unroll
        for (int b = 0; b < 2; ++b)
#pragma unroll
            for (int m = 0; m < 4; ++m)
#pragma unroll
                for (int n = 0; n < 2; ++n) acc[a][b][m][n] = (f32x4){0.f, 0.f, 0.f, 0.f};
    bf16x8 At[4][2], B0[2][2], B1[2][2];
    const char* cA = a_base(g, cur); const char* cB = (const char*)g.Bt + (size_t)cur.pn * tstep;
    S.a_ready(cur);
    if constexpr (SP2) {
        PG8_STAGE(PG8_SB(0, 0), cB, voffB); PG8_STAGE(PG8_SB(0, 1), cB + hstep, voffB); PG8_STAGE(PG8_SA(0, 0), cA, voffA); PG8_STAGE(PG8_SA(0, 1), cA + hstepA, voffA);
        if (wr == 1) PG8_BAR;
        PG8_WAIT_V(2); PG8_BAR;
        PG8_STAGE(PG8_SB(1, 0), cB + kstep, voffB); PG8_STAGE(PG8_SA(1, 0), cA + kstepA, voffA); PG8_STAGE(PG8_SB(1, 1), cB + hstep + kstep, voffB);
        PG8_WAIT_V(6); PG8_BAR;
    } else {
        PG8_STAGE(PG8_SB(0, 0), cB, voffB); PG8_STAGE(PG8_SA(0, 0), cA, voffA); PG8_STAGE(PG8_SB(0, 1), cB + hstep, voffB); PG8_STAGE(PG8_SA(0, 1), cA + hstepA, voffA);
        if (wr == 1) PG8_BAR;
        PG8_WAIT_V(4); PG8_BAR;
        PG8_STAGE(PG8_SB(1, 0), cB + kstep, voffB); PG8_STAGE(PG8_SA(1, 0), cA + kstepA, voffA); PG8_STAGE(PG8_SB(1, 1), cB + hstep + kstep, voffB);
        PG8_WAIT_V(6); PG8_BAR;
    }
    for (;;) {
        const bool has_next = S.next(ui + 1, nxt);
        const char* nA = has_next ? a_base(g, nxt) : cA; const char* nB = has_next ? (const char*)g.Bt + (size_t)nxt.pn * tstep : cB;
        for (int t = 0; t < nt; t += 2) {
            const bool last = (t == nt - 2);
            const char* a1 = cA + (size_t)(t + 1) * kstepA;
            const char* a2 = last ? nA : cA + (size_t)(t + 2) * kstepA; const char* b2 = last ? nB : cB + (size_t)(t + 2) * kstep;
            const char* a3 = a2 + kstepA; const char* b3 = b2 + kstep;
            if (last && has_next) S.a_ready(nxt);
            if constexpr (SP2) {
            PG8_LDB(B0, 0, 0); PG8_LDB(B1, 0, 1); PG8_SCHED; PG8_LDA(At, 0, 0); PG8_STAGE(PG8_SA(1, 1), a1 + hstepA, voffA);
            PG8_WAIT_V(8); PG8_WAIT_L(0); PG8_BAR; PG8_MMA(0, 0, At, B0); PG8_MMA(0, 1, At, B1); PG8_BAR; PG8_SCHED;
            PG8_LDA(At, 0, 1); PG8_STAGE(PG8_SB(0, 0), b2, voffB); PG8_STAGE(PG8_SB(0, 1), b2 + hstep, voffB); PG8_STAGE(PG8_SA(0, 0), a2, voffA);
            PG8_WAIT_V(8); PG8_WAIT_L(0); PG8_BAR; PG8_MMA(1, 0, At, B0); PG8_MMA(1, 1, At, B1); PG8_BAR; PG8_SCHED;
            PG8_LDB(B0, 1, 0); PG8_LDB(B1, 1, 1); PG8_SCHED; PG8_LDA(At, 1, 0); PG8_STAGE(PG8_SA(0, 1), a2 + hstepA, voffA);
            PG8_WAIT_V(8); PG8_WAIT_L(0); PG8_BAR; PG8_MMA(0, 0, At, B0); PG8_MMA(0, 1, At, B1); PG8_BAR; PG8_SCHED;
            PG8_LDA(At, 1, 1); PG8_STAGE(PG8_SB(1, 0), b3, voffB); PG8_STAGE(PG8_SB(1, 1), b3 + hstep, voffB); PG8_STAGE(PG8_SA(1, 0), a3, voffA);
            PG8_WAIT_V(8); PG8_WAIT_L(0); PG8_BAR; PG8_MMA(1, 0, At, B0); PG8_MMA(1, 1, At, B1); PG8_BAR; PG8_SCHED;
            } else {
            PG8_LDB(B0, 0, 0); PG8_SCHED; PG8_LDA(At, 0, 0); PG8_STAGE(PG8_SA(1, 1), a1 + hstepA, voffA);
            PG8_WAIT_L(8); PG8_BAR; PG8_WAIT_L(0); PG8_MMA(0, 0, At, B0); PG8_BAR; PG8_SCHED;
            PG8_LDB(B1, 0, 1); PG8_STAGE(PG8_SB(0, 0), b2, voffB);
            PG8_BAR; PG8_WAIT_L(0); PG8_MMA(0, 1, At, B1); PG8_BAR;
            PG8_LDA(At, 0, 1); PG8_STAGE(PG8_SA(0, 0), a2, voffA);
            PG8_BAR; PG8_WAIT_L(0); PG8_MMA(1, 0, At, B0); PG8_BAR; PG8_SCHED;
            PG8_STAGE(PG8_SB(0, 1), b2 + hstep, voffB);
            PG8_WAIT_V(6); PG8_BAR; PG8_MMA(1, 1, At, B1); PG8_BAR;
            PG8_LDB(B0, 1, 0); PG8_SCHED; PG8_LDA(At, 1, 0); PG8_STAGE(PG8_SA(0, 1), a2 + hstepA, voffA);
            PG8_WAIT_L(8); PG8_BAR; PG8_WAIT_L(0); PG8_MMA(0, 0, At, B0); PG8_BAR; PG8_SCHED;
            PG8_LDB(B1, 1, 1); PG8_STAGE(PG8_SB(1, 0), b3, voffB);
            PG8_BAR; PG8_WAIT_L(0); PG8_MMA(0, 1, At, B1); PG8_BAR;
            PG8_LDA(At, 1, 1); PG8_STAGE(PG8_SA(1, 0), a3, voffA);
            PG8_BAR; PG8_WAIT_L(0); PG8_MMA(1, 0, At, B0); PG8_BAR; PG8_SCHED;
            PG8_STAGE(PG8_SB(1, 1), b3 + hstep, voffB);
            PG8_WAIT_V(6); PG8_BAR; PG8_MMA(1, 1, At, B1); PG8_BAR;
            }
        }
        if constexpr (ALIGN_EPI) { if (wr == 0) PG8_BAR; }
        if constexpr (!Epi::AFTER_DRAIN) { E(acc, cur, wr, wc, fr, fq); S.done(cur); }
        if (!has_next) break;
#pragma unroll
        for (int a = 0; a < 2; ++a)
#pragma unroll
            for (int b = 0; b < 2; ++b)
#pragma unroll
                for (int m = 0; m < 4; ++m)
#pragma unroll
                    for (int n = 0; n < 2; ++n) acc[a][b][m][n] = (f32x4){0.f, 0.f, 0.f, 0.f};
        cur = nxt; cA = nA; cB = nB; ++ui;
        if constexpr (ALIGN_EPI) { if (wr == 1) PG8_BAR; }
    }
    PG8_WAIT_V(0);
    if constexpr (!ALIGN_EPI) { if (wr == 0) PG8_BAR; }
    PG8_BAR;
    if constexpr (Epi::AFTER_DRAIN) { E.fused(acc, cur, wr, wc, fr, fq, lds, wid, lane); S.done(cur); }
#undef PG8_SA
#undef PG8_SB
#undef PG8_STAGE
#undef PG8_LDA
#undef PG8_LDB
#undef PG8_MMA
#undef PG8_WAIT_V
#undef PG8_WAIT_L
#undef PG8_BAR
#undef PG8_SCHED
}
}

using pg8::bf16_t; using pg8::bf16x8; using pg8::f32x4; using pg8::u32x4; using pg8::Unit;
#define LAS __attribute__((address_space(3)))
#define GAS_ __attribute__((address_space(1)))
typedef LAS unsigned char* ldsp;
typedef float f32x16 __attribute__((ext_vector_type(16)));
typedef short s16x4 __attribute__((ext_vector_type(4)));
typedef float f32x2_t __attribute__((ext_vector_type(2)));
typedef __bf16 bf16x2_t __attribute__((ext_vector_type(2)));
typedef unsigned u32x2 __attribute__((ext_vector_type(2)));

constexpr int NB = 16, T = 4096, D = 1024, M = NB * T, FF = 2816;
constexpr int ZP0 = 2816, ZP1 = 3072;
constexpr int C_AQP = 0, C_AKC = 512, C_AVC = 640, C_AKS = 768, C_AVS = 896, C_AKW = 1024, C_AVW = 1152, C_BQ = 1280, C_BK = 1792, C_BV = 1920, C_GATE = 2048, C_AQR = 2304;
constexpr float LOG2E = 1.4426950408889634f;
constexpr float C2 = 0.125f * LOG2E;
constexpr float NORM_EPS = 1e-5f;
constexpr float NEG_INF = -__builtin_huge_valf();

constexpr size_t MiB = 1u << 20;
constexpr size_t WS_BAR = 1536 * 1024;
constexpr size_t WS_COS = 0, WS_SIN = 512 * 1024, WS_BIAS1 = 1 * MiB, WS_LSE = 2 * MiB, WS_HID = 6 * MiB, WS_KVC = 14 * MiB;
constexpr size_t W_IN = 22 * MiB, W_OUTE = W_IN + 2304ull * 1024 * 2, W_QKV = W_OUTE + 2 * MiB, W_OUTO = W_QKV + 6 * MiB, W_GU0 = W_OUTO + 2 * MiB, W_GU1 = W_GU0 + 11 * MiB,
                 W_DN0 = W_GU1 + 11 * MiB, W_DN1 = W_DN0 + 5632ull * 1024, W_W1 = W_DN1 + 5632ull * 1024, W_W2 = W_W1 + 2 * MiB, W_END = W_W2 + 256 * 1024;
static_assert(W_END <= 72 * MiB, "weights");
constexpr size_t WS_XN = 72 * MiB;
constexpr size_t WS_Z = 200 * MiB;
constexpr size_t WS_XB = 592 * MiB;
constexpr size_t WS_SS = 720 * MiB;
constexpr size_t WS_END = 724 * MiB;

constexpr int LDS_BYTES = 147456;
constexpr int LDS_WSF = 143360;
constexpr int LDS_BARST = 145472;
constexpr int LDS_NSA_RING = 65536, LDS_NSA_IMP = 98304, NSA_IMP_STRIDE = 4352;

struct Params { const float* in[17]; float* out; unsigned char* ws; float inv_freq[32]; };

#define LDS_WAIT() asm volatile("s_waitcnt lgkmcnt(0)" ::: "memory")
__device__ __forceinline__ unsigned f2bf(float f) { unsigned u = __builtin_bit_cast(unsigned, f); return (u + 0x7fffu + ((u >> 16) & 1u)) >> 16; }
__device__ __forceinline__ unsigned pk2(float lo, float hi) { f32x2_t v = {lo, hi}; bf16x2_t b = __builtin_convertvector(v, bf16x2_t); return __builtin_bit_cast(unsigned, b); }
__device__ __forceinline__ float bf2f(bf16_t v) { return __builtin_bit_cast(float, (unsigned)v << 16); }
__device__ __forceinline__ float wave_sum(float v) {
#pragma unroll
    for (int o = 1; o < 64; o <<= 1) v += __shfl_xor(v, o);
    return v;
}
__device__ __forceinline__ float fexp2(float x) { return __builtin_amdgcn_exp2f(x); }
__device__ __forceinline__ float silu_f(float g) { return g * __builtin_amdgcn_rcpf(1.0f + __expf(-g)); }
__device__ __forceinline__ float sigmoid_f(float g) { return __builtin_amdgcn_rcpf(1.0f + __expf(-g)); }


__device__ __forceinline__ void rows_rstd(float (&rs)[2][4], const float* SS, int row0, int fq) {
    f32x4 q[2][4];
#pragma unroll
    for (int ai = 0; ai < 2; ++ai)
#pragma unroll
        for (int m = 0; m < 4; ++m) q[ai][m] = *(const GAS_ f32x4*)(SS + (size_t)(row0 + ai * 128 + m * 16) * 16 + fq * 4);
#pragma unroll
    for (int ai = 0; ai < 2; ++ai)
#pragma unroll
        for (int m = 0; m < 4; ++m) { float s = (q[ai][m][0] + q[ai][m][1]) + (q[ai][m][2] + q[ai][m][3]); s += __shfl_xor(s, 16); s += __shfl_xor(s, 32);
            rs[ai][m] = 1.0f / sqrtf(s * (1.0f / 1024.0f) + 1e-5f); }
}
template <int HM> struct EpiZ {
    static constexpr bool PERM = true, AFTER_DRAIN = false;
    bf16_t* Z; int ldz; unsigned ropeMask, dualMask, scaleMask; int dualOff; const float* cosT; const float* sinT; const float* SS;
    __device__ __forceinline__ void operator()(const f32x4 (&acc)[2][2][4][2], const Unit& u, int wr, int wc, int fr, int fq) const {
        const int row0 = u.pm * 256 + wr * 64 + fr, col0 = u.pn * 256 + wc * 32 + 8 * fq, j0 = 16 * (wc & 1) + 4 * fq;
        float rsv[2][4];
        if (SS) rows_rstd(rsv, SS, row0, fq);
        const bool anyrope = ((ropeMask >> (2 * u.pn)) & 3u) != 0u;
#pragma unroll
        for (int ai = 0; ai < 2; ++ai) {
            f32x4 cc[4], ss[4];
            if (anyrope) {
#pragma unroll
                for (int m = 0; m < 4; ++m) { const int t = (row0 + ai * 128 + m * 16) & (T - 1); cc[m] = *(const GAS_ f32x4*)(cosT + t * 32 + j0); ss[m] = *(const GAS_ f32x4*)(sinT + t * 32 + j0); }
            }
            asm volatile("" ::: "memory");
#pragma unroll
            for (int m = 0; m < 4; ++m) {
                const int row = row0 + ai * 128 + m * 16;
                const f32x4 c4 = cc[m], s4 = ss[m];
                bf16_t* rowp = HM ? Z + ((size_t)(((row >> 12) * 3 + (col0 >> 10)) * 16 + ((col0 & 1023) >> 6)) * T + (row & (T - 1))) * 64 + (col0 & 63) : Z + (size_t)row * ldz + col0;
                constexpr int bjstep = HM ? 2 * T * 64 : 128;
                const float rs = SS ? rsv[ai][m] : 1.0f;
#pragma unroll
                for (int bj = 0; bj < 2; ++bj) {
                    const int h = u.pn * 2 + bj;
                    if (HM == 0 && col0 + bj * 128 >= 2072) continue;
                    const float sc = ((scaleMask >> h) & 1u) ? rs * C2 : rs;
                    f32x4 v0 = acc[ai][bj][m][0] * sc, v1 = acc[ai][bj][m][1] * sc;
                    int off = bj * bjstep;
                    if ((dualMask >> h) & 1u) { u32x4 w; w.x = pk2(v0[0], v0[1]); w.y = pk2(v0[2], v0[3]); w.z = pk2(v1[0], v1[1]); w.w = pk2(v1[2], v1[3]); *(GAS_ u32x4*)(rowp + off) = w; off += dualOff; }
                    if ((ropeMask >> h) & 1u) {
                        f32x4 a, b2;
                        a[0] = v0[0] * c4[0] - v0[1] * s4[0]; a[1] = v0[1] * c4[0] + v0[0] * s4[0];
                        a[2] = v0[2] * c4[1] - v0[3] * s4[1]; a[3] = v0[3] * c4[1] + v0[2] * s4[1];
                        b2[0] = v1[0] * c4[2] - v1[1] * s4[2]; b2[1] = v1[1] * c4[2] + v1[0] * s4[2];
                        b2[2] = v1[2] * c4[3] - v1[3] * s4[3]; b2[3] = v1[3] * c4[3] + v1[2] * s4[3];
                        v0 = a; v1 = b2;
                    }
                    u32x4 w; w.x = pk2(v0[0], v0[1]); w.y = pk2(v0[2], v0[3]); w.z = pk2(v1[0], v1[1]); w.w = pk2(v1[2], v1[3]);
                    *(GAS_ u32x4*)(rowp + off) = w;
                }
                asm volatile("" ::: "memory");
            }
        }
    }
};
struct EpiSwiglu {
    static constexpr bool PERM = true, AFTER_DRAIN = false;
    bf16_t* H; int ldh; const float* SS;
    __device__ __forceinline__ void operator()(const f32x4 (&acc)[2][2][4][2], const Unit& u, int wr, int wc, int fr, int fq) const {
        const int row0 = u.pm * 256 + wr * 64 + fr, hc0 = u.pn * 128 + wc * 32 + 8 * fq;
        float rsv[2][4];
        rows_rstd(rsv, SS, row0, fq);
#pragma unroll
        for (int ai = 0; ai < 2; ++ai)
#pragma unroll
            for (int m = 0; m < 4; ++m) {
                bf16_t* rowp = H + (size_t)(row0 + ai * 128 + m * 16) * ldh + hc0;
                const float rs = rsv[ai][m];
                const f32x4 g0 = acc[ai][0][m][0] * rs, g1 = acc[ai][0][m][1] * rs, u0 = acc[ai][1][m][0] * rs, u1 = acc[ai][1][m][1] * rs;
                u32x4 w; w.x = pk2(silu_f(g0[0]) * u0[0], silu_f(g0[1]) * u0[1]); w.y = pk2(silu_f(g0[2]) * u0[2], silu_f(g0[3]) * u0[3]);
                w.z = pk2(silu_f(g1[0]) * u1[0], silu_f(g1[1]) * u1[1]); w.w = pk2(silu_f(g1[2]) * u1[2], silu_f(g1[3]) * u1[3]);
                *(GAS_ u32x4*)rowp = w;
                asm volatile("" ::: "memory");
            }
    }
};
template <bool BASE_F32> struct EpiRes {
    static constexpr bool PERM = true, AFTER_DRAIN = false;
    const float* basef; bf16_t* XB; float* SS; int ldc;
    __device__ __forceinline__ void operator()(const f32x4 (&acc)[2][2][4][2], const Unit& u, int wr, int wc, int fr, int fq) const {
        const int row0 = u.pm * 256 + wr * 64 + fr, col0 = u.pn * 256 + wc * 32 + 8 * fq;
#pragma unroll
        for (int ai = 0; ai < 2; ++ai) {
            f32x4 bs[4][2][2]; u32x4 bh[4][2];
#pragma unroll
            for (int m = 0; m < 4; ++m) { const size_t off = (size_t)(row0 + ai * 128 + m * 16) * ldc + col0;
#pragma unroll
                for (int bj = 0; bj < 2; ++bj) {
                    if (BASE_F32) { bs[m][bj][0] = *(const GAS_ f32x4*)(basef + off + bj * 128); bs[m][bj][1] = *(const GAS_ f32x4*)(basef + off + bj * 128 + 4); }
                    else bh[m][bj] = *(const GAS_ u32x4*)(XB + off + bj * 128); } }
            asm volatile("" ::: "memory");
#pragma unroll
            for (int m = 0; m < 4; ++m) {
                const size_t off = (size_t)(row0 + ai * 128 + m * 16) * ldc + col0;
                float ssq = 0.f;
#pragma unroll
                for (int bj = 0; bj < 2; ++bj) {
                    f32x4 b0, b1;
                    if (BASE_F32) { b0 = bs[m][bj][0]; b1 = bs[m][bj][1]; }
                    else { const u32x4 h = bh[m][bj];
                        b0 = (f32x4){__builtin_bit_cast(float, h.x << 16), __builtin_bit_cast(float, h.x & 0xffff0000u), __builtin_bit_cast(float, h.y << 16), __builtin_bit_cast(float, h.y & 0xffff0000u)};
                        b1 = (f32x4){__builtin_bit_cast(float, h.z << 16), __builtin_bit_cast(float, h.z & 0xffff0000u), __builtin_bit_cast(float, h.w << 16), __builtin_bit_cast(float, h.w & 0xffff0000u)}; }
                    const f32x4 v0 = b0 + acc[ai][bj][m][0], v1 = b1 + acc[ai][bj][m][1];
                    ssq += ((v0[0] * v0[0] + v0[1] * v0[1]) + (v0[2] * v0[2] + v0[3] * v0[3])) + ((v1[0] * v1[0] + v1[1] * v1[1]) + (v1[2] * v1[2] + v1[3] * v1[3]));
                    u32x4 w; w.x = pk2(v0[0], v0[1]); w.y = pk2(v0[2], v0[3]); w.z = pk2(v1[0], v1[1]); w.w = pk2(v1[2], v1[3]); *(GAS_ u32x4*)(XB + off + bj * 128) = w;
                }
                ssq += __shfl_xor(ssq, 16); ssq += __shfl_xor(ssq, 32);
                if (fq == 0) *(GAS_ float*)(SS + (size_t)(row0 + ai * 128 + m * 16) * 16 + u.pn * 4 + wc) = ssq;
            }
            asm volatile("" ::: "memory");
        }
    }
};
template <int ACT> struct EpiB {
    static constexpr bool PERM = true, AFTER_DRAIN = false;
    bf16_t* O; int ldc; const float* bias;
    __device__ __forceinline__ void operator()(const f32x4 (&acc)[2][2][4][2], const Unit& u, int wr, int wc, int fr, int fq) const {
        const int row0 = u.pm * 256 + wr * 64 + fr, col0 = u.pn * 256 + wc * 32 + 8 * fq;
#pragma unroll
        for (int ai = 0; ai < 2; ++ai)
#pragma unroll
            for (int m = 0; m < 4; ++m) {
                bf16_t* rowp = O + (size_t)(row0 + ai * 128 + m * 16) * ldc + col0;
#pragma unroll
                for (int bj = 0; bj < 2; ++bj) {
                    f32x4 v0 = acc[ai][bj][m][0], v1 = acc[ai][bj][m][1];
                    if (bias) { v0 = v0 + *(const GAS_ f32x4*)(bias + col0 + bj * 128); v1 = v1 + *(const GAS_ f32x4*)(bias + col0 + bj * 128 + 4); }
                    if (ACT == 1) {
#pragma unroll
                        for (int e = 0; e < 4; ++e) { v0[e] = silu_f(v0[e]); v1[e] = silu_f(v1[e]); } }
                    u32x4 w; w.x = pk2(v0[0], v0[1]); w.y = pk2(v0[2], v0[3]); w.z = pk2(v1[0], v1[1]); w.w = pk2(v1[2], v1[3]);
                    *(GAS_ u32x4*)(rowp + bj * 128) = w;
                }
                asm volatile("" ::: "memory");
            }
    }
};
__device__ __forceinline__ int crow(int r, int hi) { return (r & 3) + 8 * (r >> 2) + 4 * hi; }
__device__ __forceinline__ float xh_max(float v) { auto rr = __builtin_amdgcn_permlane32_swap(__float_as_uint(v), __float_as_uint(v), false, false); return fmaxf(__uint_as_float(rr[0]), __uint_as_float(rr[1])); }
__device__ __forceinline__ float xh_sum(float v) { auto rr = __builtin_amdgcn_permlane32_swap(__float_as_uint(v), __float_as_uint(v), false, false); return __uint_as_float(rr[0]) + __uint_as_float(rr[1]); }
#define GAS __attribute__((address_space(1)))
__device__ __forceinline__ u32x4 ldg16(const bf16_t* p) { return *(const GAS u32x4*)p; }
__device__ __forceinline__ void tile_store(ldsp buf, const u32x4& k, const u32x4& v, int key, int ch) {
    *(LAS u32x4*)(buf + ch * 1024 + ((key ^ (2 * ch)) << 4)) = k;
    *(LAS u32x4*)(buf + 8192 + (ch >> 2) * 4096 + (key >> 4) * 1024 + (key & 15) * 64 + (ch & 3) * 16) = v;
}
__device__ __forceinline__ void q_load(bf16x8 (&qr)[4], const bf16_t* qrow, int hi) {
#pragma unroll
    for (int d0 = 0; d0 < 4; ++d0) qr[d0] = *(const GAS bf16x8*)(qrow + d0 * 16 + hi * 8);
}
__device__ __forceinline__ float max3f(float a, float b, float c) { float r; asm("v_max3_f32 %0, %1, %2, %3" : "=v"(r) : "v"(a), "v"(b), "v"(c)); return r; }
__device__ __forceinline__ void qk_tile(f32x16& p0, f32x16& p1, const ldsp Kt, const bf16x8 (&qr)[4], const f32x16& cin, int r32, int hi) {
    const ldsp kb = Kt + hi * 1024; const int ks = (r32 ^ (2 * hi)) << 4;
    __builtin_amdgcn_s_setprio(1);
#pragma unroll
    for (int d0 = 0; d0 < 4; ++d0) {
        const ldsp kp = kb + d0 * 2048 + (ks ^ (64 * d0));
        const bf16x8 b0 = *(const LAS bf16x8*)(kp), b1 = *(const LAS bf16x8*)(kp + 512);
        if (d0 == 0) { p0 = __builtin_amdgcn_mfma_f32_32x32x16_bf16(b0, qr[0], cin, 0, 0, 0); p1 = __builtin_amdgcn_mfma_f32_32x32x16_bf16(b1, qr[0], cin, 0, 0, 0); }
        else { p0 = __builtin_amdgcn_mfma_f32_32x32x16_bf16(b0, qr[d0], p0, 0, 0, 0); p1 = __builtin_amdgcn_mfma_f32_32x32x16_bf16(b1, qr[d0], p1, 0, 0, 0); }
    }
    __builtin_amdgcn_s_setprio(0);
    asm volatile("s_nop 15\n\ts_nop 7" : "+v"(p0), "+v"(p1));
}
__device__ __forceinline__ void mask_tile(f32x16& p0, f32x16& p1, int lo, int hq, int hi) {
    const bool nl = __any(lo > 0), nh = __any(hq < 63);
    if (nh && nl) {
#pragma unroll
        for (int r = 0; r < 16; ++r) { const int kk = crow(r, hi);
            if (!(kk >= lo && kk <= hq)) p0[r] = NEG_INF;
            if (!(kk + 32 >= lo && kk + 32 <= hq)) p1[r] = NEG_INF; }
    } else if (nh) {
        const int h2 = hq - 4 * hi;
#pragma unroll
        for (int r = 0; r < 16; ++r) { const int kc = (r & 3) + 8 * (r >> 2);
            if (kc > h2) p0[r] = NEG_INF;
            if (kc + 32 > h2) p1[r] = NEG_INF; }
    } else if (nl) {
        const int l2 = lo - 4 * hi;
#pragma unroll
        for (int r = 0; r < 16; ++r) { const int kc = (r & 3) + 8 * (r >> 2);
            if (kc < l2) p0[r] = NEG_INF;
            if (kc + 32 < l2) p1[r] = NEG_INF; }
    }
}
__device__ __forceinline__ float tile_max(const f32x16& p0, const f32x16& p1) {
    float a = max3f(p0[0], p0[1], p1[0]), b = max3f(p0[2], p0[3], p1[1]); a = max3f(a, p1[2], p1[3]);
#pragma unroll
    for (int r = 4; r < 16; r += 4) { a = max3f(a, p0[r], p0[r + 1]); b = max3f(b, p0[r + 2], p0[r + 3]); a = max3f(a, p1[r], p1[r + 1]); b = max3f(b, p1[r + 2], p1[r + 3]); }
    return xh_max(max3f(a, b, b));
}
__device__ __forceinline__ void splat16(f32x16& v, float x) {
#pragma unroll
    for (int r = 0; r < 16; ++r) v[r] = x;
    asm volatile("" : "+v"(v));
}
constexpr float SM_THR = 6.0f;
__device__ __forceinline__ void sm_update(f32x16& p0, f32x16& p1, float& mref, f32x16& negm, float& l, f32x16 (&o)[2], bool first, LAS float* wsf, int r32, int hi) {
    const float rm = tile_max(p0, p1);
    if (first || __any(rm > SM_THR)) {
        const float dl = first ? ((rm == NEG_INF) ? 0.f : rm) : fmaxf(rm, 0.f);
        mref += dl;
#pragma unroll
        for (int r = 0; r < 16; ++r) { p0[r] -= dl; p1[r] -= dl; }
        splat16(negm, -mref);
        if (!first) {
            const float f = fexp2(-dl);
            l *= f;
            if (hi == 0) wsf[r32] = f;
            LDS_WAIT();
#pragma unroll
            for (int r = 0; r < 16; ++r) { const float g = wsf[crow(r, hi)]; o[0][r] *= g; o[1][r] *= g; }
            LDS_WAIT();
        }
    }
    float s = 0.f;
#pragma unroll
    for (int r = 0; r < 16; ++r) { p0[r] = fexp2(p0[r]); p1[r] = fexp2(p1[r]); s += p0[r] + p1[r]; }
    l += s;
}
__device__ __forceinline__ s16x4 vtr(const ldsp p) { typedef short v4i16_t __attribute__((ext_vector_type(4))); return __builtin_bit_cast(s16x4, __builtin_amdgcn_ds_read_tr16_b64_v4i16((LAS v4i16_t*)p)); }
__device__ __forceinline__ void pv_tile(f32x16 (&o)[2], const ldsp Vt, const f32x16& p0, const f32x16& p1, int lane, int hi) {
    u32x4 pw[4];
    pw[0] = (u32x4){pk2(p0[0], p0[1]), pk2(p0[2], p0[3]), pk2(p0[4], p0[5]), pk2(p0[6], p0[7])};
    pw[1] = (u32x4){pk2(p0[8], p0[9]), pk2(p0[10], p0[11]), pk2(p0[12], p0[13]), pk2(p0[14], p0[15])};
    pw[2] = (u32x4){pk2(p1[0], p1[1]), pk2(p1[2], p1[3]), pk2(p1[4], p1[5]), pk2(p1[6], p1[7])};
    pw[3] = (u32x4){pk2(p1[8], p1[9]), pk2(p1[10], p1[11]), pk2(p1[12], p1[13]), pk2(p1[14], p1[15])};
    const ldsp vp = Vt + ((lane >> 4) & 1) * 32 + (lane & 3) * 8 + (4 * hi + ((lane & 15) >> 2)) * 64;
    __builtin_amdgcn_s_setprio(1);
#pragma unroll
    for (int d0 = 0; d0 < 2; ++d0)
#pragma unroll
        for (int ks = 0; ks < 4; ++ks) {
            const s16x4 lo = vtr(vp + d0 * 4096 + ks * 1024), hh = vtr(vp + d0 * 4096 + ks * 1024 + 512);
            const bf16x8 vf = (bf16x8){lo[0], lo[1], lo[2], lo[3], hh[0], hh[1], hh[2], hh[3]};
            o[d0] = __builtin_amdgcn_mfma_f32_32x32x16_bf16(__builtin_bit_cast(bf16x8, pw[ks]), vf, o[d0], 0, 0, 0);
        }
    __builtin_amdgcn_s_setprio(0);
}
__device__ __forceinline__ void attn_step(const ldsp Kt, const ldsp Vt, const bf16x8 (&qr)[4], f32x16 (&o)[2], float& mref, f32x16& negm, float& l, int lo, int hq, bool en, bool first, LAS float* wsf, int lane, int r32, int hi) {
    f32x16 p0, p1;
    qk_tile(p0, p1, Kt, qr, negm, r32, hi);
    if (!__all(en)) { const float pen = en ? 0.f : NEG_INF;
#pragma unroll
        for (int r = 0; r < 16; ++r) { p0[r] += pen; p1[r] += pen; } }
    mask_tile(p0, p1, lo, hq, hi);
    sm_update(p0, p1, mref, negm, l, o, first, wsf, r32, hi);
    pv_tile(o, Vt, p0, p1, lane, hi);
}
__device__ __forceinline__ void rows_axpy(f32x16 (&acc)[2], const f32x16 (&o)[2], float f, LAS float* wsf, int r32, int hi, bool init) {
    LDS_WAIT();
    if (hi == 0) wsf[r32] = f;
    LDS_WAIT();
#pragma unroll
    for (int r = 0; r < 16; ++r) { const float g = wsf[crow(r, hi)];
        if (init) { acc[0][r] = o[0][r] * g; acc[1][r] = o[1][r] * g; } else { acc[0][r] += o[0][r] * g; acc[1][r] += o[1][r] * g; } }
    LDS_WAIT();
}

template <class F> __device__ __forceinline__ void stage_store(const f32x16 (&ot)[2], ldsp lds, int w, int lane, int r32, int hi, F rowp) {
    LAS float* stg = (LAS float*)(lds + 65536 + w * 8704);
#pragma unroll
    for (int d0 = 0; d0 < 2; ++d0)
#pragma unroll
        for (int r = 0; r < 16; ++r) stg[crow(r, hi) * 68 + d0 * 32 + r32] = ot[d0][r];
    LDS_WAIT();
#pragma unroll
    for (int i = 0; i < 4; ++i) {
        const int row = i * 8 + (lane >> 3);
        const f32x4 x0 = *(const LAS f32x4*)(stg + row * 68 + (lane & 7) * 8), x1 = *(const LAS f32x4*)(stg + row * 68 + (lane & 7) * 8 + 4);
        u32x4 ow; ow.x = pk2(x0[0], x0[1]); ow.y = pk2(x0[2], x0[3]); ow.z = pk2(x1[0], x1[1]); ow.w = pk2(x1[2], x1[3]);
        *(GAS u32x4*)(rowp(row) + (lane & 7) * 8) = ow;
    }
    LDS_WAIT();
}

__device__ __forceinline__ void b_unit(const bf16_t* Z, bf16_t* MIX, const float* sinks, ldsp lds, int b, int kvh, int qb, unsigned& gt, int wave0) {
    int tid_; asm volatile("v_mbcnt_lo_u32_b32 %0, -1, 0\n\tv_mbcnt_hi_u32_b32 %0, -1, %0" : "=&v"(tid_)); tid_ += wave0 * 64; const int tid = tid_, lane = tid & 63, w = __builtin_amdgcn_readfirstlane(tid >> 6), r32 = lane & 31, hi = lane >> 5;
    const int g = r32 >> 3, qq = r32 & 7, tq = 64 * qb + 8 * w + qq, head = kvh * 4 + g, key = tid >> 3, ch = tid & 7;
    LAS float* wsf = (LAS float*)(lds + LDS_WSF) + w * 64;
    const size_t tok = (size_t)b * T + tq;
    bf16x8 qr[4]; q_load(qr, Z + tok * ZP0 + C_BQ + head * 64, hi);
    float m = *(const GAS float*)(sinks + head) * LOG2E, l = (hi == 0) ? 1.f : 0.f;
    f32x16 o[2], negm; splat16(negm, -m);
    splat16(o[0], 0.f); splat16(o[1], 0.f);
    const int n0 = qb >= 2 ? qb - 2 : 0;
    const bf16_t* kvp = Z + ((size_t)b * T + key) * ZP0 + kvh * 64 + ch * 8;
    u32x4 rk0 = ldg16(kvp + (size_t)(64 * n0) * ZP0 + C_BK), rv0 = ldg16(kvp + (size_t)(64 * n0) * ZP0 + C_BV), rk1 = rk0, rv1 = rv0;
    if (n0 + 1 <= qb) { rk1 = ldg16(kvp + (size_t)(64 * (n0 + 1)) * ZP0 + C_BK); rv1 = ldg16(kvp + (size_t)(64 * (n0 + 1)) * ZP0 + C_BV); }
    tile_store(lds + (gt & 1u) * 16384, rk0, rv0, key, ch);
    if (n0 + 2 <= qb) { rk0 = ldg16(kvp + (size_t)(64 * (n0 + 2)) * ZP0 + C_BK); rv0 = ldg16(kvp + (size_t)(64 * (n0 + 2)) * ZP0 + C_BV); }
    __syncthreads();
#define B_STEP(n, RK, RV) do { \
        const ldsp buf = lds + (gt & 1u) * 16384, nxt = lds + ((gt + 1u) & 1u) * 16384; \
        if ((n) < qb) tile_store(nxt, RK, RV, key, ch); \
        if ((n) + 3 <= qb) { RK = ldg16(kvp + (size_t)(64 * ((n) + 3)) * ZP0 + C_BK); RV = ldg16(kvp + (size_t)(64 * ((n) + 3)) * ZP0 + C_BV); } \
        attn_step(buf, buf + 8192, qr, o, m, negm, l, tq - 127 - 64 * (n), tq - 64 * (n), true, false, wsf, lane, r32, hi); \
        __syncthreads(); ++gt; } while (0)
    for (int n = n0; n <= qb; n += 2) { B_STEP(n, rk1, rv1); if (n + 1 <= qb) B_STEP(n + 1, rk0, rv0); }
#undef B_STEP
    const float lt = xh_sum(l);
    f32x16 ot[2];
    rows_axpy(ot, o, 1.0f / lt, wsf, r32, hi, true);
    stage_store(ot, lds, w, lane, r32, hi, [=](int q) { return MIX + ((size_t)b * T + 64 * qb + 8 * w + (q & 7)) * 1024 + 512 + (kvh * 4 + (q >> 3)) * 64; });
}

__device__ __forceinline__ void nsa_unit(const bf16_t* Z, const bf16_t* KVC, bf16_t* MIX, ldsp lds, int b, int kvh, int qb, unsigned& gt, int wave0) {
    int tid_; asm volatile("v_mbcnt_lo_u32_b32 %0, -1, 0\n\tv_mbcnt_hi_u32_b32 %0, -1, %0" : "=&v"(tid_)); tid_ += wave0 * 64; const int tid = tid_, lane = tid & 63, w = __builtin_amdgcn_readfirstlane(tid >> 6), r32 = lane & 31, hi = lane >> 5;
    const int g = r32 >> 3, qq = r32 & 7, tq = 64 * qb + 8 * w + qq, head = kvh * 4 + g, key = tid >> 3, ch = tid & 7;
    LAS float* wsf = (LAS float*)(lds + LDS_WSF) + w * 64;
    const size_t tok = (size_t)b * T + tq;
    const bf16_t* zrow = Z + tok * ZP0;
    const int nct = (4 * qb + 3 + 63) >> 6;
    {
        const bf16_t* kv = KVC + ((size_t)(b * 2 + kvh) * 256 + key) * 512 + ch * 8;
        for (int ct = 0; ct < nct; ++ct) { const u32x4 k = ldg16(kv + (size_t)ct * 64 * 512), v = ldg16(kv + (size_t)ct * 64 * 512 + 256); tile_store(lds + ct * 16384, k, v, key, ch); }
    }
    const GAS bf16_t* zg = (const GAS bf16_t*)(zrow + C_GATE + head * 3);
    const unsigned gpk = (unsigned)zg[0] | ((unsigned)zg[1] << 16), gp2 = (unsigned)zg[2];
#define GATE0() sigmoid_f(__builtin_bit_cast(float, gpk << 16))
#define GATE1() sigmoid_f(__builtin_bit_cast(float, gpk & 0xffff0000u))
#define GATE2() sigmoid_f(__builtin_bit_cast(float, gp2 << 16))
    bf16x8 qr[4]; q_load(qr, zrow + C_AQP + head * 64, hi);
    __syncthreads();
    float m = 0.f, l = 0.f;
    f32x16 o[2], ot[2], negm; splat16(negm, 0.f);
    splat16(o[0], 0.f); splat16(o[1], 0.f);
    const int cmax = (tq - 31) >> 4;
    for (int ct = 0; ct < nct; ++ct) attn_step(lds + ct * 16384, lds + ct * 16384 + 8192, qr, o, m, negm, l, 0, cmax - 64 * ct, true, ct == 0, wsf, lane, r32, hi);
    const float ltc = xh_sum(l), inv = ltc > 0.f ? 1.0f / ltc : 0.f;
    unsigned long long selmask = ~0ull;
    if (qb >= 16) {
        LAS float* G = (LAS float*)(lds + LDS_NSA_IMP + w * NSA_IMP_STRIDE); LAS float* L = G + 512;
        for (int ct = 0; ct < nct; ++ct) {
            f32x16 p0, p1;
            qk_tile(p0, p1, lds + ct * 16384, qr, negm, r32, hi);
            mask_tile(p0, p1, 0, cmax - 64 * ct, hi);
#pragma unroll
            for (int r = 0; r < 16; ++r) { p0[r] = fexp2(p0[r]) * inv; p1[r] = fexp2(p1[r]) * inv; }
#pragma unroll
            for (int hf = 0; hf < 2; ++hf)
#pragma unroll
                for (int grp = 0; grp < 4; ++grp) {
                    float gs, ls;
                    if (hf == 0) { gs = (p0[4 * grp] + p0[4 * grp + 1]) + (p0[4 * grp + 2] + p0[4 * grp + 3]); ls = p0[4 * grp + 3]; }
                    else         { gs = (p1[4 * grp] + p1[4 * grp + 1]) + (p1[4 * grp + 2] + p1[4 * grp + 3]); ls = p1[4 * grp + 3]; }
                    gs += __shfl_xor(gs, 8); gs += __shfl_xor(gs, 16); ls += __shfl_xor(ls, 8); ls += __shfl_xor(ls, 16);
                    const int n = ct * 16 + hf * 8 + 2 * grp + hi;
                    if (g == 0) { G[qq * 64 + n] = gs; L[qq * 68 + n + 1] = ls; }
                }
        }
        LDS_WAIT();
#pragma unroll 1
        for (int q8 = 0; q8 < 8; ++q8) {
            float v = G[q8 * 64 + lane] + (lane > 0 ? L[q8 * 68 + lane] : 0.f);
            v = (lane > qb) ? -1.f : v;
            v = (lane == 0) ? 3e38f : (lane == qb) ? 2e38f : (lane == qb - 1) ? 1e38f : v;
            int rank = 0;
#pragma unroll
            for (int j = 0; j < 64; ++j) { const float vj = __uint_as_float(__builtin_amdgcn_readlane(__float_as_uint(v), j)); rank += (vj > v) ? 1 : 0; }
            const unsigned long long mk = __ballot(rank < 16);
            if (qq == q8) selmask = mk;
        }
    }
    rows_axpy(ot, o, GATE0() * inv, wsf, r32, hi, true);
    q_load(qr, zrow + C_AQR + head * 64, hi);
    const int ns = qb + 1, w0 = qb >= 8 ? qb - 8 : 0, ntile = ns + (qb - w0 + 1);
    m = 0.f; l = 0.f; splat16(negm, 0.f);
    splat16(o[0], 0.f); splat16(o[1], 0.f);
    const bf16_t* kvp = Z + ((size_t)b * T + key) * ZP0 + kvh * 64 + ch * 8;
#define NSA_LOAD(j, RK, RV) do { const bool nw_ = (j) >= ns; const int nn_ = nw_ ? w0 + (j) - ns : (j); \
        RK = ldg16(kvp + (size_t)(64 * nn_) * ZP0 + (nw_ ? C_AKW : C_AKS)); RV = ldg16(kvp + (size_t)(64 * nn_) * ZP0 + (nw_ ? C_AVW : C_AVS)); } while (0)
    u32x4 rk0, rv0, rk1, rv1;
    NSA_LOAD(0, rk0, rv0); NSA_LOAD(1, rk1, rv1);
    tile_store(lds + LDS_NSA_RING + (gt & 1u) * 16384, rk0, rv0, key, ch);
    if (2 < ntile) NSA_LOAD(2, rk0, rv0);
    __syncthreads();
    LAS float* slab = (LAS float*)(lds + w * 8192) + lane;
#pragma unroll
    for (int k = 0; k < 16; ++k) { slab[k * 64] = ot[0][k]; slab[(16 + k) * 64] = ot[1][k]; }
#define NSA_STEP(i, RK, RV) do { \
        const bool isw = (i) >= ns; const int n = isw ? w0 + (i) - ns : (i); \
        const ldsp buf = lds + LDS_NSA_RING + (gt & 1u) * 16384, nxt = lds + LDS_NSA_RING + ((gt + 1u) & 1u) * 16384; \
        if ((i) + 1 < ntile) tile_store(nxt, RK, RV, key, ch); \
        if ((i) + 3 < ntile) NSA_LOAD((i) + 3, RK, RV); \
        if ((i) == ns) { \
            const float lt = xh_sum(l); f32x16 t2[2]; \
            rows_axpy(t2, o, GATE1() / lt, wsf, r32, hi, true); \
            _Pragma("unroll") for (int k = 0; k < 16; ++k) { slab[k * 64] += t2[0][k]; slab[(16 + k) * 64] += t2[1][k]; } \
            m = 0.f; l = 0.f; splat16(negm, 0.f); \
            splat16(o[0], 0.f); splat16(o[1], 0.f); \
        } \
        const bool en = isw ? true : (((selmask >> n) & 1ull) != 0ull); \
        const int lo = isw ? tq - 511 - 64 * n : 0, hq = tq - 64 * n; \
        if (__any(en)) attn_step(buf, buf + 8192, qr, o, m, negm, l, lo, hq, en, (i) == 0 || (i) == ns, wsf, lane, r32, hi); \
        __syncthreads(); ++gt; } while (0)
    for (int i = 0; i < ntile; i += 2) { NSA_STEP(i, rk1, rv1); if (i + 1 < ntile) NSA_STEP(i + 1, rk0, rv0); }
#undef NSA_STEP
#undef NSA_LOAD
    {
        const float lt = xh_sum(l);
        rows_axpy(ot, o, GATE2() / lt, wsf, r32, hi, true);
#pragma unroll
        for (int k = 0; k < 16; ++k) { ot[0][k] += slab[k * 64]; ot[1][k] += slab[(16 + k) * 64]; }
    }
    stage_store(ot, lds, w, lane, r32, hi, [=](int q) { return MIX + ((size_t)b * T + 64 * qb + 8 * w + (q & 7)) * 1024 + (kvh * 4 + (q >> 3)) * 64; });
    __syncthreads();
#undef GATE0
#undef GATE1
#undef GATE2
}

__device__ __forceinline__ void c_phase(const bf16_t* Z, bf16_t* MIX, float* LSE, ldsp lds, int pi, int bx, int G, unsigned& gt, int wave0, int ucount) {
    int tid_; asm volatile("v_mbcnt_lo_u32_b32 %0, -1, 0\n\tv_mbcnt_hi_u32_b32 %0, -1, %0" : "=&v"(tid_)); tid_ += wave0 * 64; const int tid = tid_, lane = tid & 63, w = __builtin_amdgcn_readfirstlane(tid >> 6), r32 = lane & 31, hi = lane >> 5;
    const int hsel = w >> 2, gq = (w < 4) ? w : 7 - w, key = tid >> 3, ch = tid & 7;
    const int ldil = 2 * pi, dil = 1 << ldil, lnb = 5 - ldil;
    LAS float* wsf = (LAS float*)(lds + LDS_WSF) + w * 64;
    const size_t tstride = (size_t)64 * dil * 64;
    const unsigned kvlane = (unsigned)(key * dil * 64 + ch * 8), qlane = (unsigned)(r32 * dil * 64), olane = (unsigned)((lane >> 3) * dil * 1024 + (lane & 7) * 8), llane = (unsigned)(r32 * dil * 16);
#define C_DEC(u_, b_, hp_, rs_, blk_) const int blk_ = (u_) & ((1 << lnb) - 1), rs_ = ((u_) >> lnb) & (dil - 1), hp_ = ((u_) >> 5) & 7, b_ = (u_) >> 8
#define C_KVP(b_, hp_, rs_) (Z + ((size_t)(((b_) * 3 + 1) * 16 + 2 * (hp_)) * T + (rs_)) * 64)
#define C_QROW(b_, hp_, rs_, blk_) (Z + ((size_t)(((b_) * 3) * 16 + 2 * (hp_) + hsel) * T + (size_t)(128 * (blk_) + 32 * gq) * dil + (rs_)) * 64 + qlane)
#define C_LOADP(p_) do { const bf16_t* q_ = (p_); rka = ldg16(q_ + kvlane); rva = ldg16(q_ + (size_t)16 * T * 64 + kvlane); rkb = ldg16(q_ + (size_t)T * 64 + kvlane); rvb = ldg16(q_ + (size_t)17 * T * 64 + kvlane); } while (0)
    const u32x4 z4 = {0u, 0u, 0u, 0u};
    u32x4 rka = z4, rva = z4, rkb = z4, rvb = z4;
    const int per = (ucount + G - 1) / G, uend = (bx + 1) * per < ucount ? (bx + 1) * per : ucount;
    int u = bx * per;
    if (u >= uend) return;
    {   C_DEC(u, b, hp, rs, blk); const int kt0 = blk >= 1 ? 2 * blk - 2 : 0; const bf16_t* kvp = C_KVP(b, hp, rs);
        C_LOADP(kvp + kt0 * tstride);
        { const ldsp b0 = lds + (gt & 1u) * 32768; tile_store(b0, rka, rva, key, ch); tile_store(b0 + 16384, rkb, rvb, key, ch); }
        C_LOADP(kvp + (kt0 + 1) * tstride);
        __syncthreads(); }
    for (; u < uend; ++u) {
        C_DEC(u, b, hp, rs, blk);
        const int head = 2 * hp + hsel, q0 = 128 * blk + 32 * gq, ql = q0 + r32;
        const int kt0 = blk >= 1 ? 2 * blk - 2 : 0, kt1 = 2 * blk + 1;
        const bf16_t* kvp = C_KVP(b, hp, rs);
        const bool has_next = u + 1 < uend;
        const int un = has_next ? u + 1 : u;
        C_DEC(un, bn, hpn, rsn, blkn);
        const int kt0n = blkn >= 1 ? 2 * blkn - 2 : 0;
        const bf16_t* kvpn = C_KVP(bn, hpn, rsn) + kt0n * tstride;
        bf16x8 qr[4]; q_load(qr, C_QROW(b, hp, rs, blk), hi);
        GAS float* lsep = (GAS float*)(LSE + ((size_t)b * T + (size_t)q0 * dil + rs) * 16 + head + llane);
        bf16_t* orow = MIX + ((size_t)b * T + (size_t)q0 * dil + rs) * 1024 + head * 64 + olane;
        const size_t ostep = (size_t)8 * dil * 1024;
        u32x4 orun[4] = {z4, z4, z4, z4}; float lse_old = 0.f;
        float m = 0.f, l = 0.f; bool started = false;
        f32x16 o[2], negm; splat16(negm, 0.f);
        splat16(o[0], 0.f); splat16(o[1], 0.f);
        for (int kt = kt0; kt <= kt1; ++kt) {
            const ldsp buf = lds + (gt & 1u) * 32768, nxt = lds + ((gt + 1u) & 1u) * 32768;
            if (kt == kt1 - 1) {
                if (pi > 0) { lse_old = *lsep;
#pragma unroll
                    for (int i = 0; i < 4; ++i) orun[i] = ldg16(orow + i * ostep); }
            }
            if (64 * kt <= q0 + 31 && 64 * kt + 63 >= q0 - 128) {
                attn_step(buf + hsel * 16384, buf + hsel * 16384 + 8192, qr, o, m, negm, l, ql - 128 - 64 * kt, ql - 64 * kt, true, !started, wsf, lane, r32, hi); started = true; }
            if (kt < kt1 || has_next) { tile_store(nxt, rka, rva, key, ch); tile_store(nxt + 16384, rkb, rvb, key, ch); }
            if (kt + 2 <= kt1) C_LOADP(kvp + (kt + 2) * tstride);
            else if (has_next) { if (kt == kt1 - 1) C_LOADP(kvpn); else C_LOADP(kvpn + tstride); }
            __syncthreads(); ++gt;
        }
        const float lt = xh_sum(l), lse = m + __log2f(lt);
        float wa = 0.f, wb = 1.0f / lt;
        if (pi > 0) {
            const float mx = fmaxf(lse_old, lse), nl = mx + __log2f(fexp2(lse_old - mx) + fexp2(lse - mx));
            wa = fexp2(lse_old - nl); wb = fexp2(lse - nl) / lt;
            if (pi < 2 && hi == 0) *lsep = nl;
        } else if (hi == 0) *lsep = lse;
        LDS_WAIT();
        if (hi == 0) { wsf[r32] = wa; wsf[32 + r32] = wb; }
        LDS_WAIT();
        LAS float* stg = (LAS float*)(lds + 65536 + w * 8704);
#pragma unroll
        for (int d0 = 0; d0 < 2; ++d0)
#pragma unroll
            for (int r = 0; r < 16; ++r) { const int q = crow(r, hi); stg[q * 68 + d0 * 32 + r32] = wsf[32 + q] * o[d0][r]; }
        LDS_WAIT();
#pragma unroll
        for (int i = 0; i < 4; ++i) {
            const int row = i * 8 + (lane >> 3);
            const f32x4 x0 = *(const LAS f32x4*)(stg + row * 68 + (lane & 7) * 8), x1 = *(const LAS f32x4*)(stg + row * 68 + (lane & 7) * 8 + 4);
            float v[8] = {x0[0], x0[1], x0[2], x0[3], x1[0], x1[1], x1[2], x1[3]};
            if (pi > 0) { const float fa = wsf[row];
#pragma unroll
                for (int k = 0; k < 4; ++k) { const unsigned wd = orun[i][k]; v[2 * k] += fa * __builtin_bit_cast(float, wd << 16); v[2 * k + 1] += fa * __builtin_bit_cast(float, wd & 0xffff0000u); } }
            u32x4 ow; ow.x = pk2(v[0], v[1]); ow.y = pk2(v[2], v[3]); ow.z = pk2(v[4], v[5]); ow.w = pk2(v[6], v[7]);
            *(GAS u32x4*)(orow + i * ostep) = ow;
        }
        LDS_WAIT();
    }
#undef C_DEC
#undef C_KVP
#undef C_QROW
#undef C_LOADP
}
__device__ __forceinline__ int il64(int p) { return (p & 1) ? (p >> 1) + 32 : (p >> 1); }
__device__ __forceinline__ int src_col(int mapid, int n) {
    switch (mapid) {
    case 0:
        if (n < 512) return (n & ~63) + il64(n & 63);
        if (n < 768) return n;
        if (n < 896) return (n & ~63) + il64(n & 63);
        if (n < 1024) return n;
        if (n < 1152) return (n & ~63) + il64(n & 63);
        if (n < 1280) return n;
        if (n < 1792) { const int q = n - 1280; return 1304 + (q & ~63) + il64(q & 63); }
        if (n < 1920) { const int q = n - 1792; return 1816 + (q & ~63) + il64(q & 63); }
        if (n < 2048) return 1944 + (n - 1920);
        if (n < 2072) return 1280 + (n - 2048);
        return -1;
    case 2: return n < 2048 ? (n & ~63) + il64(n & 63) : n;
    case 3: { const int hid = (n >> 8) * 128 + (n & 127); return ((n >> 7) & 1) ? FF + hid : hid; }
    case 4: return n < 64 ? il64(n) : -1;
    case 5: return n < 64 ? n : -1;
    default: return n;
    }
}
__device__ __forceinline__ void tr_item(const float* W, int K, int Nlog, const float* gain, bf16_t* Wt, int mapid, int nblk, LAS float* scr, int item, int lane) {
    const int kb = item / nblk, nb = item % nblk, k0 = 64 * kb, n0 = 32 * nb;
    const int src = src_col(mapid, n0 + (lane & 31));
#pragma unroll 8
    for (int i = 0; i < 32; ++i) { const int kk = 2 * i + (lane >> 5); float v = 0.f;
        if (src >= 0) { v = *(const GAS float*)(W + (size_t)(k0 + kk) * Nlog + src); if (gain) v *= *(const GAS float*)(gain + k0 + kk); }
        scr[kk * 33 + (lane & 31)] = v; }
    LDS_WAIT();
    const int c = lane & 7;
#pragma unroll
    for (int j = 0; j < 4; ++j) { const int n = (lane >> 3) + 8 * j; const LAS float* s = scr + (8 * c) * 33 + n;
        u32x4 o; o.x = pk2(s[0 * 33], s[1 * 33]); o.y = pk2(s[2 * 33], s[3 * 33]); o.z = pk2(s[4 * 33], s[5 * 33]); o.w = pk2(s[6 * 33], s[7 * 33]);
        *(GAS u32x4*)(Wt + (size_t)(n0 + n) * K + k0 + 8 * c) = o; }
    LDS_WAIT();
}
__device__ __forceinline__ void row_to_bf16_ss(const float* xrow, bf16_t* orow, float* ssrow, int lane) {
    const GAS f32x4* xr = (const GAS f32x4*)xrow + 2 * lane;
    f32x4 v[4]; float s = 0.f;
#pragma unroll
    for (int j = 0; j < 2; ++j) { v[2 * j] = xr[128 * j]; v[2 * j + 1] = xr[128 * j + 1]; }
#pragma unroll
    for (int j = 0; j < 4; ++j) s += (v[j].x * v[j].x + v[j].y * v[j].y) + (v[j].z * v[j].z + v[j].w * v[j].w);
    s = wave_sum(s);
    GAS u32x4* o16 = (GAS u32x4*)orow + lane;
#pragma unroll
    for (int j = 0; j < 2; ++j) { u32x4 w; w.x = pk2(v[2 * j].x, v[2 * j].y); w.y = pk2(v[2 * j].z, v[2 * j].w); w.z = pk2(v[2 * j + 1].x, v[2 * j + 1].y); w.w = pk2(v[2 * j + 1].z, v[2 * j + 1].w); o16[64 * j] = w; }
    if (lane < 16) *(GAS float*)(ssrow + lane) = (lane == 0) ? s : 0.f;
}
__device__ __forceinline__ void rms_row_final(const bf16_t* xbrow, float* orow, const float* gain, const float* ssrow, int lane) {
    GAS f32x4* xo = (GAS f32x4*)orow + 2 * lane; const GAS f32x4* gr = (const GAS f32x4*)gain + 2 * lane; const GAS u32x4* xr = (const GAS u32x4*)xbrow + lane;
    u32x4 h[2];
#pragma unroll
    for (int j = 0; j < 2; ++j) h[j] = xr[64 * j];
    const float s = lane < 16 ? *(const GAS float*)(ssrow + lane) : 0.f;
    const float rstd = 1.0f / sqrtf(wave_sum(s) * (1.0f / D) + NORM_EPS);
#pragma unroll
    for (int j = 0; j < 2; ++j) {
        const f32x4 a = (f32x4){__builtin_bit_cast(float, h[j].x << 16), __builtin_bit_cast(float, h[j].x & 0xffff0000u), __builtin_bit_cast(float, h[j].y << 16), __builtin_bit_cast(float, h[j].y & 0xffff0000u)};
        const f32x4 b = (f32x4){__builtin_bit_cast(float, h[j].z << 16), __builtin_bit_cast(float, h[j].z & 0xffff0000u), __builtin_bit_cast(float, h[j].w << 16), __builtin_bit_cast(float, h[j].w & 0xffff0000u)};
        xo[128 * j] = (a * rstd) * gr[128 * j]; xo[128 * j + 1] = (b * rstd) * gr[128 * j + 1]; }
}
__device__ __forceinline__ void sincos_d(float a, float& c, float& s) {
    const double x = (double)a; const double kq = __builtin_rint(x * 0.63661977236758134308);
    double r = __builtin_fma(-kq, 1.57079632679489655800, x); r = __builtin_fma(-kq, 6.12323399573676603587e-17, r);
    const double r2 = r * r;
    const double sn = r * (1.0 + r2 * (-1.0 / 6 + r2 * (1.0 / 120 + r2 * (-1.0 / 5040 + r2 * (1.0 / 362880 + r2 * (-1.0 / 39916800 + r2 * (1.0 / 6227020800.0)))))));
    const double cs = 1.0 + r2 * (-0.5 + r2 * (1.0 / 24 + r2 * (-1.0 / 720 + r2 * (1.0 / 40320 + r2 * (-1.0 / 3628800 + r2 * (1.0 / 479001600.0 + r2 * (-1.0 / 87178291200.0)))))));
    const int q = (int)kq & 3;
    const double so = (q == 0) ? sn : (q == 1) ? cs : (q == 2) ? -sn : -cs, co = (q == 0) ? cs : (q == 1) ? -sn : (q == 2) ? -cs : sn;
    c = (float)co; s = (float)so;
}

typedef unsigned v4u __attribute__((ext_vector_type(4)));
#define XB_TMO      128
#define XB_XCNT(j)  (256  + 64 * (j))
#define XB_XSUB(j)  (1280 + 64 * (j))
#define XB_XGEN(j)  (2304 + 64 * (j))
#define XB_TOP      3328
#define XB_TOPGEN   3392
#define XCD_BAR_WORDS 3456
#define XB_SPIN_CAP (1u << 18)

__device__ __forceinline__ unsigned xb_ld(unsigned* p)              { return __hip_atomic_load(p, __ATOMIC_RELAXED, __HIP_MEMORY_SCOPE_AGENT); }
__device__ __forceinline__ unsigned xb_add(unsigned* p, unsigned v) { return __hip_atomic_fetch_add(p, v, __ATOMIC_RELAXED, __HIP_MEMORY_SCOPE_AGENT); }
__device__ __forceinline__ unsigned xb_xcc_id() { return (unsigned)__builtin_amdgcn_s_getreg((3 << 11) | 20) & 0xFu; }
#define XB_SPIN(cond, bar) do { unsigned _sp = 0; while (cond) { __builtin_amdgcn_s_sleep(1); \
    if ((++_sp & 255u) == 0u) { if (xb_ld(&(bar)[XB_TMO])) break; if (_sp > XB_SPIN_CAP) { atomicAdd(&(bar)[XB_TMO], 1u); break; } } } } while (0)

struct XcdBarrier {
    unsigned* bar; unsigned x; int w0;
    volatile LAS unsigned* st;
};

__device__ __forceinline__ bool xb_thread0(int w0) { return w0 == 0 && __builtin_amdgcn_mbcnt_hi(~0u, __builtin_amdgcn_mbcnt_lo(~0u, 0u)) == 0u; }
__device__ __forceinline__ XcdBarrier xcd_barrier_post(unsigned* bar, volatile LAS unsigned* st, int w0) {
    XcdBarrier b; b.bar = bar; b.x = xb_xcc_id(); b.st = st; b.w0 = w0;
    if (xb_thread0(w0)) (void)xb_add(&bar[XB_XCNT(b.x)], 1u);
    return b;
}
__device__ __forceinline__ void xcd_barrier_complete(unsigned* bar, unsigned x, unsigned& nloc, unsigned& nx) {
    const unsigned G = gridDim.x * gridDim.y * gridDim.z;
    unsigned sum, cnt, mine, sp = 0u;
    for (;;) {
        sum = 0u; cnt = 0u; mine = 0u;
#pragma unroll
        for (unsigned j = 0; j < 16; ++j) { const unsigned c = xb_ld(&bar[XB_XCNT(j)]); sum += c; cnt += (c > 0u) ? 1u : 0u; mine = (j == x) ? c : mine; }
        if (sum == G) break;
        __builtin_amdgcn_s_sleep(1);
        if ((++sp & 255u) == 0u) { if (xb_ld(&bar[XB_TMO])) break; if (sp > XB_SPIN_CAP) { atomicAdd(&bar[XB_TMO], 1u); break; } }
    }
    nloc = mine > 0u ? mine : 1u; nx = cnt > 0u ? cnt : 1u;
}

__device__ __forceinline__ void xcd_barrier(const XcdBarrier& b) {
    asm volatile("s_waitcnt vmcnt(0)" ::: "memory");
    __syncthreads();
    if (xb_thread0(b.w0)) {
        unsigned* bar = b.bar;
        __builtin_amdgcn_s_waitcnt(0);
        unsigned nloc = b.st[0], nx = b.st[1];
        if (nloc == 0u) { xcd_barrier_complete(bar, b.x, nloc, nx); b.st[0] = nloc; b.st[1] = nx; }
        const unsigned old = xb_add(&bar[XB_XSUB(b.x)], 1u);
        const unsigned gen = old / nloc;
        if (old + 1u == (gen + 1u) * nloc) {
            __builtin_amdgcn_fence(__ATOMIC_RELEASE, "agent");
            asm volatile("s_waitcnt vmcnt(0)" ::: "memory");
            const unsigned og = xb_add(&bar[XB_TOP], 1u);
            const unsigned tg = og / nx;
            if (og + 1u == (tg + 1u) * nx) xb_add(&bar[XB_TOPGEN], 1u);
            else XB_SPIN(xb_ld(&bar[XB_TOPGEN]) == tg, bar);
            __builtin_amdgcn_fence(__ATOMIC_ACQUIRE, "agent");
            xb_add(&bar[XB_XGEN(b.x)], 1u);
            asm volatile("s_waitcnt vmcnt(0)" ::: "memory");
        } else {
            XB_SPIN(xb_ld(&bar[XB_XGEN(b.x)]) == gen, bar);
            __builtin_amdgcn_fence(__ATOMIC_ACQUIRE, "agent");
            asm volatile("s_waitcnt vmcnt(0)" ::: "memory");
        }
    }
    __syncthreads();
}

__global__ void __launch_bounds__(512, 2) fwd_mega(Params P) {
    extern __shared__ __attribute__((aligned(16))) unsigned char lds_raw[];
    cg::grid_group grid = cg::this_grid();
    const ldsp lds = (ldsp)lds_raw;
    const int G = gridDim.x, bx = blockIdx.x, NGW = G * 8;
    const int wave0 = __builtin_amdgcn_readfirstlane((int)threadIdx.x >> 6);
#define TID_SETUP() int tid_; asm volatile("v_mbcnt_lo_u32_b32 %0, -1, 0\n\tv_mbcnt_hi_u32_b32 %0, -1, %0" : "=&v"(tid_)); tid_ += wave0 * 64; const int tid = tid_, lane = tid & 63, wave = __builtin_amdgcn_readfirstlane(tid >> 6), gw = bx * 8 + wave; (void)lane; (void)gw
#define WS_SETUP() unsigned char* ws = P.ws; asm volatile("" : "+s"(ws)); \
    float* cosT = (float*)(ws + WS_COS); float* sinT = (float*)(ws + WS_SIN); float* bias1 = (float*)(ws + WS_BIAS1); float* LSE = (float*)(ws + WS_LSE); \
    bf16_t* HID = (bf16_t*)(ws + WS_HID); bf16_t* KVC = (bf16_t*)(ws + WS_KVC); bf16_t* XN = (bf16_t*)(ws + WS_XN); bf16_t* MIX = XN; bf16_t* Z = (bf16_t*)(ws + WS_Z); bf16_t* H = Z; float* X = P.out; bf16_t* XB = (bf16_t*)(ws + WS_XB); float* SS = (float*)(ws + WS_SS); (void)XB; (void)SS; \
    (void)cosT; (void)sinT; (void)bias1; (void)LSE; (void)HID; (void)KVC; (void)XN; (void)MIX; (void)Z; (void)H; (void)X
    unsigned gt = 0;
    unsigned* barw = (unsigned*)(P.ws + WS_BAR);
    volatile LAS unsigned* barst = (volatile LAS unsigned*)(lds + LDS_BARST);
    { TID_SETUP();
    if (tid == 0) { barst[0] = 0u; barst[1] = 0u; }
    if (bx == 0) { for (int i = tid; i < XCD_BAR_WORDS; i += 512) __hip_atomic_store(barw + i, 0u, __ATOMIC_RELAXED, __HIP_MEMORY_SCOPE_AGENT); } }
    __syncthreads();

    {
        TID_SETUP(); WS_SETUP();
        LAS float* scr = (LAS float*)(lds + wave * 8704);
        constexpr int I0 = 16 * 72, I1 = 16 * 32, I2 = 16 * 96, I3 = 16 * 32, I4 = 16 * 176, I6 = 44 * 32, I8 = 32 * 8, I10 = 4 * 8;
        constexpr int NIT = I0 + I1 + I2 + I3 + 2 * I4 + 2 * I6 + 2 * I8 + 2 * I10;
        for (int it = gw; it < NIT; it += NGW) {
            int r = it;
            if (r < I0) { tr_item(P.in[4], 1024, 2072, P.in[1], (bf16_t*)(ws + W_IN), 0, 72, scr, r, lane); continue; } r -= I0;
            if (r < I1) { tr_item(P.in[5], 1024, 1024, nullptr, (bf16_t*)(ws + W_OUTE), 1, 32, scr, r, lane); continue; } r -= I1;
            if (r < I2) { tr_item(P.in[13], 1024, 3072, P.in[1] + 1024, (bf16_t*)(ws + W_QKV), 2, 96, scr, r, lane); continue; } r -= I2;
            if (r < I3) { tr_item(P.in[14], 1024, 1024, nullptr, (bf16_t*)(ws + W_OUTO), 1, 32, scr, r, lane); continue; } r -= I3;
            if (r < I4) { tr_item(P.in[15], 1024, 5632, P.in[2], (bf16_t*)(ws + W_GU0), 3, 176, scr, r, lane); continue; } r -= I4;
            if (r < I4) { tr_item(P.in[15] + (size_t)1024 * 5632, 1024, 5632, P.in[2] + 1024, (bf16_t*)(ws + W_GU1), 3, 176, scr, r, lane); continue; } r -= I4;
            if (r < I6) { tr_item(P.in[16], 2816, 1024, nullptr, (bf16_t*)(ws + W_DN0), 1, 32, scr, r, lane); continue; } r -= I6;
            if (r < I6) { tr_item(P.in[16] + (size_t)2816 * 1024, 2816, 1024, nullptr, (bf16_t*)(ws + W_DN1), 1, 32, scr, r, lane); continue; } r -= I6;
            if (r < I8) { tr_item(P.in[8], 2048, 256, nullptr, (bf16_t*)(ws + W_W1), 1, 8, scr, r, lane); continue; } r -= I8;
            if (r < I8) { tr_item(P.in[10], 2048, 256, nullptr, (bf16_t*)(ws + W_W1) + (size_t)256 * 2048, 1, 8, scr, r, lane); continue; } r -= I8;
            if (r < I10) { tr_item(P.in[9], 256, 64, nullptr, (bf16_t*)(ws + W_W2), 4, 8, scr, r, lane); continue; } r -= I10;
            tr_item(P.in[11], 256, 64, nullptr, (bf16_t*)(ws + W_W2) + (size_t)256 * 256, 5, 8, scr, r, lane);
        }
        for (int e = bx * 512 + tid; e < T * 32; e += G * 512) { const int t = e >> 5, i = e & 31; float c, s; sincos_d((float)t * P.inv_freq[i], c, s); cosT[e] = c; sinT[e] = s; }
        if (bx >= G - 32) {
            const int c = G - 1 - bx, j = tid; const float* pe = j < 256 ? P.in[6] : P.in[7]; const float* w1 = j < 256 ? P.in[8] : P.in[10];
            float s = 0.f;
#pragma unroll 16
            for (int kk = c * 64; kk < c * 64 + 64; ++kk) s += *(const GAS float*)(pe + kk) * *(const GAS float*)(w1 + (size_t)kk * 256 + (j & 255));
            *(GAS float*)(bias1 + 512 + c * 512 + j) = s;
        }
        for (int mrow = gw; mrow < M; mrow += NGW) row_to_bf16_ss(P.in[0] + (size_t)mrow * D, XB + (size_t)mrow * D, SS + (size_t)mrow * 16, lane);
    }
    grid.sync();
    const XcdBarrier xbar = xcd_barrier_post(barw, barst, wave0);
#define GRID_BAR() do { XcdBarrier t_ = xbar; asm volatile("" : "+s"(t_.x), "+s"(t_.bar)); xcd_barrier(t_); } while (0)
    {   WS_SETUP();
        if (bx == 0) { TID_SETUP(); float s = 0.f;
#pragma unroll 8
            for (int c = 0; c < 32; ++c) s += *(const GAS float*)(bias1 + 512 + c * 512 + tid);
            *(GAS float*)(bias1 + tid) = s; }
        pg8::Gemm g{XB, (const bf16_t*)(ws + W_IN), M, 2304, 1024, 1024, 128, 0, (long)256 * 1024 * 2, 0, 0};
        pg8::StaticOrder S; S.init(M, 2304, G, bx);
        const unsigned rope = 0xFu | (1u << 6) | (1u << 8) | (0xFu << 10) | (1u << 14), dual = 0xFu, scal = 0xFu | (0xFu << 10);
        EpiZ<0> E{Z, ZP0, rope, dual, scal, C_AQR, cosT, sinT, SS};
        pg8::gemm_phase<EpiZ<0>, pg8::StaticOrder, true, true>(lds, g, S, E, wave0);
    }
    GRID_BAR();
    {   WS_SETUP();
        pg8::Gemm g{Z, (const bf16_t*)(ws + W_W1), 32 * 256, 512, 2048, 16 * ZP0, ZP0 * 2, 1, (long)T * ZP0 * 2, 64 * 2, 128 * 2};
        g.A = Z + C_AKC;
        pg8::StaticOrder S; S.init(32 * 256, 512, G, bx);
        EpiB<1> E{HID, 512, bias1};
        pg8::gemm_phase<EpiB<1>, pg8::StaticOrder, true, true>(lds, g, S, E, wave0);
        asm volatile("s_waitcnt vmcnt(0)" ::: "memory");
        __builtin_amdgcn_fence(__ATOMIC_RELEASE, "agent"); __syncthreads(); __builtin_amdgcn_fence(__ATOMIC_ACQUIRE, "agent");
        {
            pg8::Gemm g2{HID, (const bf16_t*)(ws + W_W2), 32 * 256, 512, 256, 512, 128, 0, (long)256 * 512 * 2, 0, 256 * 2};
            EpiB<0> E2{KVC, 512, nullptr};
            pg8::gemm_phase<EpiB<0>, pg8::StaticOrder, true, true>(lds, g2, S, E2, wave0);
        }
        __syncthreads();
        if (G > 64) {
            if (bx < 64) { for (int j = 0; j < 1; ++j) { const int u = bx + j, qb = u & 63, bh = u >> 6; b_unit(Z, MIX, P.in[12], lds, bh >> 1, bh & 1, qb, gt, wave0); } }
            else { const int per_ = (1984 + (G - 64) - 1) / (G - 64), u0_ = 64 + (bx - 64) * per_, u1_ = (u0_ + per_ < 2048) ? u0_ + per_ : 2048;
                   for (int u = u0_; u < u1_; ++u) { const int qb = u & 63, bh = u >> 6; b_unit(Z, MIX, P.in[12], lds, bh >> 1, bh & 1, qb, gt, wave0); } }
        } else { for (int u = bx; u < 2048; u += G) { const int qb = u & 63, bh = u >> 6; b_unit(Z, MIX, P.in[12], lds, bh >> 1, bh & 1, qb, gt, wave0); } }
        __syncthreads();
    }
    GRID_BAR();
    {   WS_SETUP();
        for (int i = 0; i * G + bx < 2048; ++i) { const int u = i * G + bx, j = u >> 5, lvl = j & 7, rnd = j >> 3; const int qb = 63 - (8 * rnd + ((rnd & 1) ? 7 - lvl : lvl)); const int bh = u & 31;
            nsa_unit(Z, KVC, MIX, lds, bh >> 1, bh & 1, qb, gt, wave0); }
        __syncthreads();
    }
    GRID_BAR();
    {   WS_SETUP();
        pg8::Gemm g{MIX, (const bf16_t*)(ws + W_OUTE), M, 1024, 1024, 1024, 128, 0, (long)256 * 1024 * 2, 0, 0};
        pg8::StaticOrder S; S.init(M, 1024, G, bx);
        EpiRes<false> E{nullptr, XB, SS, 1024};
        pg8::gemm_phase<EpiRes<false>, pg8::StaticOrder, true, true>(lds, g, S, E, wave0);
    }
    GRID_BAR();
    for (int layer = 0; layer < 2; ++layer) {
        if (layer == 1) {
            {   WS_SETUP();
                pg8::Gemm g{XB, (const bf16_t*)(ws + W_QKV), M, 3072, 1024, 1024, 128, 0, (long)256 * 1024 * 2, 0, 0};
                pg8::StaticOrder S; S.init(M, 3072, G, bx);
                EpiZ<1> E{Z, ZP1, 0xFFFFu, 0u, 0xFFu, 0, cosT, sinT, SS};
                pg8::gemm_phase<EpiZ<1>, pg8::StaticOrder, true, true>(lds, g, S, E, wave0);
            }
            GRID_BAR();
            for (int pi = 0; pi < 3; ++pi) {
                WS_SETUP();
                c_phase(Z, MIX, LSE, lds, pi, bx, G, gt, wave0, 4096);
                __syncthreads();
                GRID_BAR();
            }
            {   WS_SETUP();
                pg8::Gemm g{MIX, (const bf16_t*)(ws + W_OUTO), M, 1024, 1024, 1024, 128, 0, (long)256 * 1024 * 2, 0, 0};
                pg8::StaticOrder S; S.init(M, 1024, G, bx);
                EpiRes<false> E{nullptr, XB, SS, 1024};
                pg8::gemm_phase<EpiRes<false>, pg8::StaticOrder, true, true>(lds, g, S, E, wave0);
            }
            GRID_BAR();
        }
        {   WS_SETUP();
            pg8::Gemm g{XB, (const bf16_t*)(ws + (layer == 0 ? W_GU0 : W_GU1)), M, 5632, 1024, 1024, 128, 0, (long)256 * 1024 * 2, 0, 0};
            pg8::StaticOrder S; S.init(M, 5632, G, bx);
            EpiSwiglu E{H, FF, SS};
            pg8::gemm_phase<EpiSwiglu, pg8::StaticOrder, true, true>(lds, g, S, E, wave0);
        }
        GRID_BAR();
        {   WS_SETUP();
            pg8::Gemm g{H, (const bf16_t*)(ws + (layer == 0 ? W_DN0 : W_DN1)), M, 1024, FF, FF, 128, 0, (long)256 * FF * 2, 0, 0};
            pg8::StaticOrder S; S.init(M, 1024, G, bx, 1);
            EpiRes<false> E{nullptr, XB, SS, 1024};
            pg8::gemm_phase<EpiRes<false>, pg8::StaticOrder, true, true>(lds, g, S, E, wave0);
        }
        GRID_BAR();
    }
    { TID_SETUP(); WS_SETUP();
    for (int mrow = gw; mrow < M; mrow += NGW) rms_row_final(XB + (size_t)mrow * D, X + (size_t)mrow * D, P.in[3], SS + (size_t)mrow * 16, lane); }
}

extern "C" void kernel_launch(void* const* d_in, const int* in_sizes, int n_in, void* d_out, int out_size, void* d_ws, size_t ws_size, hipStream_t stream) {
    static int grid = 0;
    if (grid == 0) {
        if (n_in != 17 || out_size != M * D || ws_size < WS_END) { fprintf(stderr, "kernel_launch: unexpected problem shape (n_in %d out %d ws %zu)\n", n_in, out_size, ws_size); grid = -1; return; }
        int dev = 0, cus = 0, per_cu = 0;
        hipGetDevice(&dev); hipDeviceGetAttribute(&cus, hipDeviceAttributeMultiprocessorCount, dev);
        hipFuncSetAttribute((const void*)fwd_mega, hipFuncAttributeMaxDynamicSharedMemorySize, LDS_BYTES);
        hipOccupancyMaxActiveBlocksPerMultiprocessor(&per_cu, (const void*)fwd_mega, 512, LDS_BYTES);
        if (per_cu < 1) { fprintf(stderr, "kernel_launch: occupancy query says %d blocks per CU\n", per_cu); per_cu = 1; }
        (void)hipGetLastError();
        grid = cus * 1;
    }
    if (grid < 0) return;
    Params p{};
    for (int i = 0; i < 17; ++i) p.in[i] = (const float*)d_in[i];
    p.out = (float*)d_out; p.ws = (unsigned char*)d_ws;
    for (int i = 0; i < 32; ++i) p.inv_freq[i] = 1.0f / powf(10000.0f, (float)(2 * i) / 64.0f);
    void* args[] = {&p};
    hipError_t e = hipLaunchCooperativeKernel((const void*)fwd_mega, dim3(grid), dim3(512), args, LDS_BYTES, stream);
    if (e != hipSuccess) fprintf(stderr, "cooperative launch failed: %s (grid %d)\n", hipGetErrorString(e), grid);
}
```
